# Optimizing an MI355X kernel written in HIP

```python
import jax, jax.numpy as jnp
from jax import lax
import numpy as np

D_MODEL = 1024
BATCH = 8
SEQ = 4096
DEPTH = 1

HEAD_DIM = 64
N_HEADS = (D_MODEL // 2) // HEAD_DIM
N_KV_HEADS = 2
GROUP = N_HEADS // N_KV_HEADS
Q_COLS = N_HEADS * HEAD_DIM
KV_COLS = N_KV_HEADS * HEAD_DIM
WINDOW = 128
ATTN_BLOCK = 128
NUM_BUCKETS = 32
MAX_DISTANCE = 128
CONV_CH = D_MODEL - Q_COLS
CONV_WIDTH = 31
IN_COLS = Q_COLS + 2 * KV_COLS + 2 * CONV_CH
N_EXPERTS = 256
TOP_K = 8
N_GROUPS = 8
TOPK_GROUPS = 4
EXPERT_HIDDEN = 256
SHARED_HIDDEN = 256
ROUTED_SCALE = 2.5
MOE_BLOCK = 128
EPS = 1e-6

kernel_name = "hybrid_conv_swa_sink_t5bias_moe_adaln"


def _rms_norm(x):
    xf = x.astype(jnp.float32)
    return (xf * lax.rsqrt(jnp.mean(xf * xf, axis=-1, keepdims=True) + EPS)).astype(x.dtype)


def _layer_norm(x, g, b):
    xf = x.astype(jnp.float32)
    mu = jnp.mean(xf, axis=-1, keepdims=True)
    var = jnp.mean(jnp.square(xf - mu), axis=-1, keepdims=True)
    y = (xf - mu) * lax.rsqrt(var + EPS) * g.astype(jnp.float32) + b.astype(jnp.float32)
    return y.astype(x.dtype)


def _t5_causal_buckets(dist):
    n = np.maximum(dist, 0)
    max_exact = NUM_BUCKETS // 2
    large = max_exact + (np.log(np.maximum(n, 1) / max_exact) / np.log(MAX_DISTANCE / max_exact)
                         * (NUM_BUCKETS - max_exact)).astype(np.int32)
    large = np.minimum(large, NUM_BUCKETS - 1)
    return np.where(n < max_exact, n, large).astype(np.int32)


def _sliding_window_attention(q, k, v, sinks, rel_bias):
    B, S, _ = q.shape
    L = ATTN_BLOCK
    nb = S // L
    q = q.reshape(B, nb, L, N_KV_HEADS, GROUP, HEAD_DIM)
    k = k.reshape(B, nb, L, N_KV_HEADS, HEAD_DIM)
    v = v.reshape(B, nb, L, N_KV_HEADS, HEAD_DIM)
    pad = ((0, 0), (1, 0), (0, 0), (0, 0), (0, 0))
    kk = jnp.concatenate([jnp.pad(k, pad)[:, :-1], k], axis=2)
    vv = jnp.concatenate([jnp.pad(v, pad)[:, :-1], v], axis=2)
    qi = np.arange(L)[:, None]
    ki = np.arange(2 * L)[None, :]
    dist = qi + L - ki
    band = (dist >= 0) & (dist < WINDOW)
    not_first = np.arange(nb)[:, None, None] > 0
    mask = band[None] & (not_first | (ki >= L)[None])
    bias = rel_bias.astype(jnp.float32)[_t5_causal_buckets(dist)]
    bias = jnp.transpose(bias, (2, 0, 1)).reshape(N_KV_HEADS, GROUP, L, 2 * L)
    logits = jnp.einsum('bnqkgd,bnskd->bnkgqs', q, kk,
                        preferred_element_type=jnp.float32) * (HEAD_DIM ** -0.5) + bias
    logits = jnp.where(jnp.asarray(mask)[None, :, None, None], logits, -jnp.inf)
    sink = sinks.astype(jnp.float32).reshape(1, 1, N_KV_HEADS, GROUP, 1, 1)
    m = jnp.maximum(jnp.max(logits, axis=-1, keepdims=True), sink)
    p = jnp.exp(logits - m)
    denom = jnp.sum(p, axis=-1) + jnp.exp(sink - m)[..., 0]
    o = jnp.einsum('bnkgqs,bnskd->bnqkgd', p, vv.astype(jnp.float32))
    o = o / jnp.transpose(denom, (0, 1, 4, 2, 3))[..., None]
    return o.reshape(B, S, Q_COLS).astype(q.dtype)


def _conv_module(a, gate, conv_w, conv_b, ln_g, ln_b):
    u = a * jax.nn.sigmoid(gate)
    u = lax.conv_general_dilated(u, conv_w[:, None, :], window_strides=(1,),
                                 padding=[(CONV_WIDTH - 1, 0)],
                                 dimension_numbers=('NWC', 'WIO', 'NWC'),
                                 feature_group_count=CONV_CH) + conv_b
    return jax.nn.silu(_layer_norm(u, ln_g, ln_b))


def _moe(h, w_router, router_bias, w_gate, w_up, w_down, w_sh_gate, w_sh_up, w_sh_down):
    B, S, D = h.shape
    T = B * S
    ht = h.reshape(T, D)
    scores = jax.nn.sigmoid(jnp.dot(ht, w_router, preferred_element_type=jnp.float32))
    sel = scores + router_bias.astype(jnp.float32)
    grp = sel.reshape(T, N_GROUPS, N_EXPERTS // N_GROUPS)
    grp_score = jnp.sum(lax.top_k(grp, 2)[0], axis=-1)
    _, gidx = lax.top_k(grp_score, TOPK_GROUPS)
    gmask = jnp.sum(jax.nn.one_hot(gidx, N_GROUPS, dtype=jnp.float32), axis=-2) > 0
    emask = jnp.repeat(gmask, N_EXPERTS // N_GROUPS, axis=-1)
    _, eidx = lax.top_k(jnp.where(emask, sel, -jnp.inf), TOP_K)
    gw = jnp.take_along_axis(scores, eidx, axis=-1)
    gw = gw / jnp.sum(gw, axis=-1, keepdims=True) * ROUTED_SCALE
    A = T * TOP_K
    flat_e = eidx.reshape(A)
    order = jnp.argsort(flat_e)
    se = flat_e[order]
    stok = (order // TOP_K).astype(jnp.int32)
    sw = gw.reshape(A)[order]
    counts = jnp.bincount(flat_e, length=N_EXPERTS)
    starts = jnp.cumsum(counts) - counts
    padded = (counts + MOE_BLOCK - 1) // MOE_BLOCK * MOE_BLOCK
    pends = jnp.cumsum(padded)
    pstarts = pends - padded
    dest = pstarts[se] + jnp.arange(A, dtype=jnp.int32) - starts[se]
    n_blocks = (A + MOE_BLOCK - 1) // MOE_BLOCK + N_EXPERTS
    P = n_blocks * MOE_BLOCK
    row_tok = jnp.full((P,), T, jnp.int32).at[dest].set(stok)
    row_w = jnp.zeros((P,), jnp.float32).at[dest].set(sw)
    blk_e = jnp.minimum(jnp.searchsorted(pends, jnp.arange(n_blocks, dtype=jnp.int32) * MOE_BLOCK,
                                         side='right'), N_EXPERTS - 1)
    h_pad = jnp.concatenate([ht, jnp.zeros((1, D), ht.dtype)], axis=0)

    def step(acc, blk):
        tok, w, e = blk
        xb = h_pad[tok]
        hid = jax.nn.silu(xb @ w_gate[e]) * (xb @ w_up[e])
        out = (hid @ w_down[e]).astype(jnp.float32) * w[:, None]
        return acc.at[tok].add(out), None

    acc, _ = lax.scan(step, jnp.zeros((T + 1, D), jnp.float32),
                      (row_tok.reshape(n_blocks, MOE_BLOCK), row_w.reshape(n_blocks, MOE_BLOCK), blk_e))
    shared = (jax.nn.silu(ht @ w_sh_gate) * (ht @ w_sh_up)) @ w_sh_down
    return (acc[:T] + shared.astype(jnp.float32)).astype(h.dtype).reshape(B, S, D)


def setup_inputs(seed: int = 0) -> dict:
    key = jax.random.key(seed)
    ks = jax.random.split(key, 24)

    def nrm(k, shape, s):
        return jax.random.normal(k, shape, jnp.float32) * s

    D = D_MODEL
    return {
        "x": nrm(ks[0], (BATCH, SEQ, D), 1.0),
        "c": nrm(ks[1], (BATCH, D), 1.0),
        "w_ada": nrm(ks[2], (DEPTH, D, 6 * D), 0.5 * D ** -0.5),
        "b_ada": nrm(ks[3], (DEPTH, 6 * D), 0.02),
        "w_in": nrm(ks[4], (DEPTH, D, IN_COLS), D ** -0.5),
        "attn_sinks": nrm(ks[5], (DEPTH, N_HEADS), 1.0),
        "rel_bias": nrm(ks[6], (NUM_BUCKETS, N_HEADS), 0.5),
        "attn_norm_g": 1.0 + nrm(ks[7], (DEPTH, Q_COLS), 0.02),
        "conv_w": nrm(ks[8], (DEPTH, CONV_WIDTH, CONV_CH), CONV_WIDTH ** -0.5),
        "conv_b": nrm(ks[9], (DEPTH, CONV_CH), 0.02),
        "conv_ln_g": 1.0 + nrm(ks[10], (DEPTH, CONV_CH), 0.02),
        "conv_ln_b": nrm(ks[11], (DEPTH, CONV_CH), 0.02),
        "w_out": nrm(ks[12], (DEPTH, D, D), D ** -0.5),
        "w_router": nrm(ks[13], (DEPTH, D, N_EXPERTS), D ** -0.5),
        "router_bias": nrm(ks[14], (DEPTH, N_EXPERTS), 0.01),
        "w_exp_gate": nrm(ks[15], (DEPTH, N_EXPERTS, D, EXPERT_HIDDEN), D ** -0.5),
        "w_exp_up": nrm(ks[16], (DEPTH, N_EXPERTS, D, EXPERT_HIDDEN), D ** -0.5),
        "w_exp_down": nrm(ks[17], (DEPTH, N_EXPERTS, EXPERT_HIDDEN, D), EXPERT_HIDDEN ** -0.5),
        "w_sh_gate": nrm(ks[18], (DEPTH, D, SHARED_HIDDEN), D ** -0.5),
        "w_sh_up": nrm(ks[19], (DEPTH, D, SHARED_HIDDEN), D ** -0.5),
        "w_sh_down": nrm(ks[20], (DEPTH, SHARED_HIDDEN, D), SHARED_HIDDEN ** -0.5),
        "final_norm_g": 1.0 + nrm(ks[21], (D,), 0.02),
    }


def reference(x, c, w_ada, b_ada, w_in, attn_sinks, rel_bias, attn_norm_g, conv_w, conv_b,
              conv_ln_g, conv_ln_b, w_out, w_router, router_bias, w_exp_gate, w_exp_up,
              w_exp_down, w_sh_gate, w_sh_up, w_sh_down, final_norm_g):
    s_q = Q_COLS
    s_k = s_q + KV_COLS
    s_v = s_k + KV_COLS
    s_a = s_v + CONV_CH
    for l in range(DEPTH):
        mod = jnp.dot(jax.nn.silu(c), w_ada[l]) + b_ada[l]
        sh1, sc1, g1, sh2, sc2, g2 = jnp.split(mod, 6, axis=-1)
        h = _rms_norm(x) * (1 + sc1[:, None]) + sh1[:, None]
        proj = h @ w_in[l]
        q = proj[..., :s_q]
        k = proj[..., s_q:s_k]
        v = proj[..., s_k:s_v]
        a = proj[..., s_v:s_a]
        gt = proj[..., s_a:]
        attn = _rms_norm(_sliding_window_attention(q, k, v, attn_sinks[l], rel_bias)) * attn_norm_g[l]
        conv = _conv_module(a, gt, conv_w[l], conv_b[l], conv_ln_g[l], conv_ln_b[l])
        mixed = jnp.concatenate([attn, conv], axis=-1) @ w_out[l]
        x = x + g1[:, None] * mixed
        h2 = _rms_norm(x) * (1 + sc2[:, None]) + sh2[:, None]
        x = x + g2[:, None] * _moe(h2, w_router[l], router_bias[l], w_exp_gate[l], w_exp_up[l],
                                    w_exp_down[l], w_sh_gate[l], w_sh_up[l], w_sh_down[l])
    return _rms_norm(x) * final_norm_g
```

```cpp
#include <hip/hip_runtime.h>
#include <cstdio>
#include <cstdint>
namespace pg8 {
#define PG8_LAS __attribute__((address_space(3)))
typedef unsigned short bf16_t;
typedef short bf16x8 __attribute__((ext_vector_type(8)));
typedef float f32x4 __attribute__((ext_vector_type(4)));
typedef unsigned u32x4 __attribute__((ext_vector_type(4)));
constexpr int BM = 256, BK = 64, HALF = 128, HTB = HALF * BK * 2  , STAGE_BYTES = 8 * HTB, NXCD = 8, WGM = 8;

__host__ __device__ __forceinline__ int lds_byte(int r, int c) { const int st = (r >> 4) * 2 + (c >> 5), rr = r & 15, cc = c & 31, ob = rr * 64 + cc * 2; return st * 1024 + (ob ^ (((ob >> 9) & 1) << 5)); }
__host__ __device__ __forceinline__ void stage_rc(int b, int& R, int& C) { const int st = b / 1024, sb = b % 1024, swz = sb ^ (((sb >> 9) & 1) << 5); R = (st >> 1) * 16 + swz / 64; C = (st & 1) * 32 + (swz % 64) / 2; }
__host__ __device__ __forceinline__ int perm32(int rho) { const int n = rho >> 4, i = rho & 15; return 8 * (i >> 2) + 4 * n + (i & 3); }

struct Unit { int pm, pn; };
struct Gemm { const bf16_t* A; const bf16_t* Bt; int M, N, K; };

struct StaticOrder {
    int nM, nN, nwg, G, c;
    __host__ __device__ void init(int M, int N, int G_, int c_) { nM = M / BM; nN = N / BM; nwg = nM * nN; G = G_; c = c_; }
    __host__ __device__ bool next(int i, Unit& u) const {
        const long L = (long)i * G + c; if (L >= nwg) return false;
        int wgid = (int)L; { const int q = nwg / NXCD, r = nwg % NXCD, xcd = wgid % NXCD, off = wgid / NXCD; wgid = (xcd < r ? xcd * (q + 1) : r * (q + 1) + (xcd - r) * q) + off; }
        const int nig = WGM * nN, gid = wgid / nig, fm = gid * WGM, gsz = (nM - fm) < WGM ? (nM - fm) : WGM;
        u.pm = fm + ((wgid % nig) % gsz); u.pn = (wgid % nig) / gsz; return true;
    }
    __device__ __forceinline__ void a_ready(const Unit&) const {}
    __device__ __forceinline__ void done(const Unit&) const {}
};

__device__ __forceinline__ unsigned cvt_pk_bf16(float lo, float hi) { unsigned r; asm volatile("v_cvt_pk_bf16_f32 %0, %1, %2" : "=v"(r) : "v"(lo), "v"(hi)); return r; }
typedef float f32x2 __attribute__((ext_vector_type(2)));

typedef float f32x2v __attribute__((ext_vector_type(2)));
typedef __bf16 bf16x2v __attribute__((ext_vector_type(2)));
__device__ __forceinline__ unsigned pkbf(float lo, float hi) { f32x2v v = {lo, hi}; bf16x2v b = __builtin_convertvector(v, bf16x2v); return __builtin_bit_cast(unsigned, b); }
__device__ __forceinline__ float silu_f(float x) { return x * __builtin_amdgcn_rcpf(1.0f + __expf(-x)); }
__device__ __forceinline__ u32x4 pack8(const f32x4& v0, const f32x4& v1) { u32x4 w; w.x = pkbf(v0[0], v0[1]); w.y = pkbf(v0[2], v0[3]); w.z = pkbf(v1[0], v1[1]); w.w = pkbf(v1[2], v1[3]); return w; }

struct EpiBf16 {
    static constexpr bool PERM = true, AFTER_DRAIN = false;
    bf16_t* O; int ldc; int cmask;
    __device__ __forceinline__ void operator()(const f32x4 (&acc)[2][2][4][2], const Unit& u, int wr, int wc, int fr, int fq) const {
        const int row0 = u.pm * BM + wr * 64 + fr, col0 = (u.pn & cmask) * BM + wc * 32 + 8 * fq;
#pragma unroll
        for (int ai = 0; ai < 2; ++ai)
#pragma unroll
            for (int m = 0; m < 4; ++m) { bf16_t* rowp = O + (size_t)(row0 + ai * HALF + m * 16) * ldc + col0;
#pragma unroll
                for (int bj = 0; bj < 2; ++bj) *(u32x4*)(rowp + bj * HALF) = pack8(acc[ai][bj][m][0], acc[ai][bj][m][1]); }
    }
};
struct EpiFp8 {
    static constexpr bool PERM = true, AFTER_DRAIN = false;
    unsigned char* O; int ldc; int cmask;
    __device__ __forceinline__ void operator()(const f32x4 (&acc)[2][2][4][2], const Unit& u, int wr, int wc, int fr, int fq) const {
        const int row0 = u.pm * BM + wr * 64 + fr, col0 = (u.pn & cmask) * BM + wc * 64 + 16 * fq;
#pragma unroll
        for (int ai = 0; ai < 2; ++ai)
#pragma unroll
            for (int m = 0; m < 4; ++m) { u32x4 w;
#pragma unroll
                for (int bj = 0; bj < 2; ++bj)
#pragma unroll
                    for (int n = 0; n < 2; ++n) { const f32x4 v = acc[ai][bj][m][n];
                        int t = __builtin_amdgcn_cvt_pk_fp8_f32(v[0], v[1], 0, false); t = __builtin_amdgcn_cvt_pk_fp8_f32(v[2], v[3], t, true); w[2 * bj + n] = (unsigned)t; }
                *(u32x4*)(O + (size_t)(row0 + ai * HALF + m * 16) * ldc + col0) = w; asm volatile("" ::: "memory"); }
    }
};
struct OneUnit {
    int pm, pn;
    __device__ __forceinline__ bool next(int i, Unit& u) const { if (i) return false; u.pm = pm; u.pn = pn; return true; }
    __device__ __forceinline__ void a_ready(const Unit&) const {}
    __device__ __forceinline__ void done(const Unit&) const {}
};
struct EpiResid {
    static constexpr bool PERM = true, AFTER_DRAIN = false;
    const float* x; float* out; const float* gate;
    __device__ __forceinline__ void operator()(const f32x4 (&acc)[2][2][4][2], const Unit& u, int wr, int wc, int fr, int fq) const {
        const int row0 = u.pm * BM + wr * 64 + fr, col0 = u.pn * BM + wc * 32 + 8 * fq;
        const float* gp = gate + (size_t)((u.pm * BM) >> 12) * 6144 + col0;
        f32x4 gv[2][2];
#pragma unroll
        for (int bj = 0; bj < 2; ++bj)
#pragma unroll
            for (int n = 0; n < 2; ++n) gv[bj][n] = *(const f32x4*)(gp + bj * HALF + 4 * n);
#pragma unroll
        for (int ai = 0; ai < 2; ++ai)
#pragma unroll
            for (int m = 0; m < 4; ++m) { const size_t off = (size_t)(row0 + ai * HALF + m * 16) * 1024 + col0;
#pragma unroll
                for (int bj = 0; bj < 2; ++bj)
#pragma unroll
                    for (int n = 0; n < 2; ++n) { const f32x4 xv = *(const f32x4*)(x + off + bj * HALF + 4 * n); *(f32x4*)(out + off + bj * HALF + 4 * n) = xv + gv[bj][n] * acc[ai][bj][m][n]; } }
    }
};
__device__ __forceinline__ void store_gateup(const f32x4 (&acc)[2][2][4][2], bf16_t* hid, int row0, int j, int wc, int fq) {
#pragma unroll
    for (int ai = 0; ai < 2; ++ai)
#pragma unroll
        for (int m = 0; m < 4; ++m) { f32x4 h0, h1;
#pragma unroll
            for (int e = 0; e < 4; ++e) { h0[e] = silu_f(acc[ai][0][m][0][e]) * acc[ai][1][m][0][e]; h1[e] = silu_f(acc[ai][0][m][1][e]) * acc[ai][1][m][1][e]; }
            *(u32x4*)(hid + (size_t)(row0 + ai * HALF + m * 16) * 256 + 128 * j + wc * 32 + 8 * fq) = pack8(h0, h1); asm volatile("" ::: "memory"); }
}
struct EpiRouterShared {
    static constexpr bool PERM = true, AFTER_DRAIN = false;
    float* logits; bf16_t* hid;
    __device__ __forceinline__ void operator()(const f32x4 (&acc)[2][2][4][2], const Unit& u, int wr, int wc, int fr, int fq) const {
        const int row0 = u.pm * BM + wr * 64 + fr;
        if (u.pn == 0) {
#pragma unroll
            for (int ai = 0; ai < 2; ++ai)
#pragma unroll
                for (int m = 0; m < 4; ++m) { float* rowp = logits + (size_t)(row0 + ai * HALF + m * 16) * 256 + wc * 32 + 8 * fq;
#pragma unroll
                    for (int bj = 0; bj < 2; ++bj)
#pragma unroll
                        for (int n = 0; n < 2; ++n) *(f32x4*)(rowp + bj * HALF + 4 * n) = acc[ai][bj][m][n]; }
        } else store_gateup(acc, hid, row0, u.pn - 1, wc, fq);
    }
};
struct EpiRouterHalf {
    static constexpr bool PERM = true, AFTER_DRAIN = false;
    float* logits;
    __device__ __forceinline__ void operator()(const f32x4 (&acc)[2][2][4][2], const Unit& u, int wr, int wc, int fr, int fq) const {
#pragma unroll
        for (int m = 0; m < 4; ++m) { float* rowp = logits + (size_t)(u.pm * BM + wr * 64 + fr + m * 16) * 256 + wc * 32 + 8 * fq;
#pragma unroll
            for (int bj = 0; bj < 2; ++bj)
#pragma unroll
                for (int n = 0; n < 2; ++n) *(f32x4*)(rowp + bj * HALF + 4 * n) = acc[0][bj][m][n]; }
    }
};
struct EpiGateUp {
    static constexpr bool PERM = true, AFTER_DRAIN = false;
    bf16_t* hid;
    __device__ __forceinline__ void operator()(const f32x4 (&acc)[2][2][4][2], const Unit& u, int wr, int wc, int fr, int fq) const {
        store_gateup(acc, hid, u.pm * BM + wr * 64 + fr, u.pn & 1, wc, fq);
    }
};
struct EpiDownScatter {
    static constexpr bool PERM = true, AFTER_DRAIN = false;
    bf16_t* y; const int* rowdst; const float* roww;
    __device__ __forceinline__ void operator()(const f32x4 (&acc)[2][2][4][2], const Unit& u, int wr, int wc, int fr, int fq) const {
        const int row0 = u.pm * BM + wr * 64 + fr, col0 = (u.pn & 3) * BM + wc * 32 + 8 * fq;
#pragma unroll
        for (int ai = 0; ai < 2; ++ai) {
            int d[4]; float w[4];
#pragma unroll
            for (int m = 0; m < 4; ++m) { const int p = row0 + ai * HALF + m * 16; d[m] = rowdst[p]; w[m] = roww[p]; }
#pragma unroll
            for (int m = 0; m < 4; ++m) { bf16_t* rowp = y + (size_t)d[m] * 1024 + col0;
#pragma unroll
                for (int bj = 0; bj < 2; ++bj) *(u32x4*)(rowp + bj * HALF) = pack8(acc[ai][bj][m][0] * w[m], acc[ai][bj][m][1] * w[m]); }
            asm volatile("" ::: "memory"); }
    }
};

struct EpiResidNorm {
    static constexpr bool PERM = true, AFTER_DRAIN = true;
    const float* x; float* out; const float* mod  ; bf16_t* h2; float* slots  ; unsigned* cnt  ; float eps;
    __device__ __forceinline__ void operator()(const f32x4 (&)[2][2][4][2], const Unit&, int, int, int, int) const {}
    __device__ __forceinline__ void fused(f32x4 (&acc)[2][2][4][2], const Unit& u, int wr, int wc, int fr, int fq, PG8_LAS unsigned char* lds, int wid, int lane) const {
        PG8_LAS float* P = (PG8_LAS float*)lds;
        PG8_LAS float* Sv = (PG8_LAS float*)(lds + 4096);
        const int row0 = u.pm * BM + wr * 64 + fr, col0 = u.pn * BM + wc * 32 + 8 * fq;
        const float* mb = mod + (size_t)((u.pm * BM) >> 12) * 6144;
        {
            f32x4 gv[2][2];
#pragma unroll
            for (int bj = 0; bj < 2; ++bj)
#pragma unroll
                for (int n = 0; n < 2; ++n) gv[bj][n] = *(const f32x4*)(mb + 2048 + col0 + bj * HALF + 4 * n);
            constexpr int XD = 2;
            f32x4 xb[XD + 1][2][2];
#pragma unroll
            for (int pb = 0; pb < XD; ++pb)
#pragma unroll
                for (int bj = 0; bj < 2; ++bj)
#pragma unroll
                    for (int n = 0; n < 2; ++n) xb[pb][bj][n] = *(const f32x4*)(x + (size_t)(row0 + (pb >> 2) * HALF + (pb & 3) * 16) * 1024 + col0 + bj * HALF + 4 * n);
#pragma unroll
            for (int blk = 0; blk < 8; ++blk) { const int ai = blk >> 2, m = blk & 3; const size_t off = (size_t)(row0 + ai * HALF + m * 16) * 1024 + col0; float s = 0.f;
                if (blk + XD < 8) { const size_t offn = (size_t)(row0 + ((blk + XD) >> 2) * HALF + ((blk + XD) & 3) * 16) * 1024 + col0;
#pragma unroll
                    for (int bj = 0; bj < 2; ++bj)
#pragma unroll
                        for (int n = 0; n < 2; ++n) xb[(blk + XD) % (XD + 1)][bj][n] = *(const f32x4*)(x + offn + bj * HALF + 4 * n); }
#pragma unroll
                for (int bj = 0; bj < 2; ++bj) {
#pragma unroll
                    for (int n = 0; n < 2; ++n) { const f32x4 v = xb[blk % (XD + 1)][bj][n] + gv[bj][n] * acc[ai][bj][m][n]; acc[ai][bj][m][n] = v;
                        s += (v[0] * v[0] + v[1] * v[1]) + (v[2] * v[2] + v[3] * v[3]); }
                    *(u32x4*)((bf16_t*)out + 2 * (off - col0) + col0 + bj * HALF) = pack8(acc[ai][bj][m][0], acc[ai][bj][m][1]); }
                s += __shfl_xor(s, 16); s += __shfl_xor(s, 32);
                if (fq == 0) P[(ai * HALF + wr * 64 + m * 16 + fr) * 4 + wc] = s; }
        }
        asm volatile("s_waitcnt lgkmcnt(0)" ::: "memory"); __builtin_amdgcn_s_barrier(); asm volatile("" ::: "memory");
        const int row = wid * 32 + (lane & 31);
        if (lane < 32) { const float tot = (P[row * 4 + 0] + P[row * 4 + 1]) + (P[row * 4 + 2] + P[row * 4 + 3]);
            __hip_atomic_store(slots + (size_t)(u.pm * BM + row) * 4 + u.pn, tot, __ATOMIC_RELAXED, __HIP_MEMORY_SCOPE_AGENT); }
        asm volatile("s_waitcnt vmcnt(0)" ::: "memory");
        if (lane == 0) __hip_atomic_fetch_add(cnt + 64 * u.pm, 1u, __ATOMIC_RELAXED, __HIP_MEMORY_SCOPE_AGENT);
        if (wid == 0) {
            unsigned spins = 0;
            while ((unsigned)__builtin_amdgcn_readfirstlane((int)__hip_atomic_load(cnt + 64 * u.pm, __ATOMIC_RELAXED, __HIP_MEMORY_SCOPE_AGENT)) < 32u) { __builtin_amdgcn_s_sleep(2); if (++spins > (1u << 22)) break; }
            __builtin_amdgcn_fence(__ATOMIC_ACQUIRE, "agent");
            asm volatile("s_waitcnt vmcnt(0)" ::: "memory");
        }
        asm volatile("s_waitcnt vmcnt(0) lgkmcnt(0)" ::: "memory"); __builtin_amdgcn_s_barrier(); asm volatile("" ::: "memory");
        if (lane < 32) { const float* sl = slots + (size_t)(u.pm * BM + row) * 4; float t4[4];
#pragma unroll
            for (int t = 0; t < 4; ++t) t4[t] = __hip_atomic_load(sl + t, __ATOMIC_RELAXED, __HIP_MEMORY_SCOPE_AGENT);
            Sv[row] = 1.0f / sqrtf(((t4[0] + t4[1]) + (t4[2] + t4[3])) * (1.0f / 1024.0f) + eps); }
        asm volatile("s_waitcnt lgkmcnt(0)" ::: "memory"); __builtin_amdgcn_s_barrier(); asm volatile("" ::: "memory");
        f32x4 shv[2][2], scv[2][2];
#pragma unroll
        for (int bj = 0; bj < 2; ++bj)
#pragma unroll
            for (int n = 0; n < 2; ++n) { shv[bj][n] = *(const f32x4*)(mb + 3072 + col0 + bj * HALF + 4 * n); scv[bj][n] = *(const f32x4*)(mb + 4096 + col0 + bj * HALF + 4 * n) + 1.0f; }
#pragma unroll
        for (int ai = 0; ai < 2; ++ai)
#pragma unroll
            for (int m = 0; m < 4; ++m) { const int r = ai * HALF + wr * 64 + m * 16 + fr; const float rs = Sv[r]; bf16_t* rowp = h2 + (size_t)(u.pm * BM + r) * 1024 + col0;
#pragma unroll
                for (int bj = 0; bj < 2; ++bj) *(u32x4*)(rowp + bj * HALF) = pack8(acc[ai][bj][m][0] * rs * scv[bj][0] + shv[bj][0], acc[ai][bj][m][1] * rs * scv[bj][1] + shv[bj][1]); }
    }
};
struct RoundSched {
    StaticOrder base; int round;
    __device__ __forceinline__ bool next(int i, Unit& u) const { if (i) return false; return base.next(round, u); }
    __device__ __forceinline__ void a_ready(const Unit&) const {}
    __device__ __forceinline__ void done(const Unit&) const {}
};
struct TileSched {
    const PG8_LAS unsigned short* tile_exp; int first, step, hi, sh;
    __device__ __forceinline__ bool next(int i, Unit& u) const {
        const int L = first + step * i; if (L >= hi) return false;
        const int pm = L >> sh; u.pm = pm; u.pn = (__builtin_amdgcn_readfirstlane((int)tile_exp[pm]) << sh) + (L & ((1 << sh) - 1)); return true;
    }
    __device__ __forceinline__ void a_ready(const Unit&) const {}
    __device__ __forceinline__ void done(const Unit&) const {}
};

template <class Epi, class Sched, bool ALIGN_EPI = false, bool SP2 = false, bool GATHER = false, bool HALFM = false>
__device__ __forceinline__ void gemm_phase(PG8_LAS unsigned char* lds, const Gemm g, const Sched& S, const Epi& E, const unsigned short* glist = nullptr, int gcnt = 0) {
    const int tid = threadIdx.x, wid = __builtin_amdgcn_readfirstlane(tid >> 6), lane = tid & 63, wr = wid >> 2, wc = wid & 3, fr = lane & 15, fq = lane >> 4;
    const int K = g.K, nt = K / BK;
    unsigned voffA[2], voffA1[2], voffB[2];
#pragma unroll
    for (int i = 0; i < 2; ++i) { int R, C; stage_rc(tid * 16 + i * 8192, R, C); const int Rb = Epi::PERM ? ((R & ~31) + perm32(R & 31)) : R;
        voffA[i] = (unsigned)(R * K + C) * 2u; voffA1[i] = voffA[i]; voffB[i] = (unsigned)(Rb * K + C) * 2u;
        if constexpr (GATHER) {
            const int ra = R < gcnt ? (int)glist[R] : 0, rb = (HALF + R) < gcnt ? (int)glist[HALF + R] : 0;
            voffA[i] = (unsigned)(ra * K + C) * 2u; voffA1[i] = (unsigned)(rb * K + C) * 2u; } }
    const size_t kstep = (size_t)(BK * 2);
    const size_t hstep = (size_t)HALF * K * 2;
    const size_t tstep = 2 * hstep;
    const size_t hstepA = GATHER ? 0 : hstep, tstepA = GATHER ? 0 : tstep;
    const unsigned ldsw = (unsigned)wid * 1024u;
    const int aoff = lds_byte(wr * 64 + fr, fq * 8), boff = lds_byte(wc * 32 + fr, fq * 8);
#define PG8_SA(b, h) (((b) * 2 + (h)) * HTB)
#define PG8_SB(b, h) ((4 + (b) * 2 + (h)) * HTB)
#define PG8_STAGE(bufoff, gbase, voff) do { _Pragma("unroll") for (int _i = 0; _i < 2; ++_i) \
        __builtin_amdgcn_global_load_lds((const unsigned*)((const char*)(gbase) + (voff)[_i]), (PG8_LAS unsigned*)(lds + (bufoff) + ldsw + _i * 8192), 16, 0, 0); } while (0)
#define PG8_LDA(dst, b, h) do { _Pragma("unroll") for (int m = 0; m < 4; ++m) _Pragma("unroll") for (int k = 0; k < 2; ++k) dst[m][k] = *(const PG8_LAS bf16x8*)(lds + PG8_SA(b, h) + aoff + m * 2048 + k * 1024); } while (0)
#define PG8_LDB(dst, b, h) do { _Pragma("unroll") for (int n = 0; n < 2; ++n) _Pragma("unroll") for (int k = 0; k < 2; ++k) dst[n][k] = *(const PG8_LAS bf16x8*)(lds + PG8_SB(b, h) + boff + n * 2048 + k * 1024); } while (0)
#define PG8_MMA(ai, bj, At, Bt) do { __builtin_amdgcn_s_setprio(1); _Pragma("unroll") for (int m = 0; m < 4; ++m) _Pragma("unroll") for (int n = 0; n < 2; ++n) _Pragma("unroll") for (int k = 0; k < 2; ++k) \
        acc[ai][bj][m][n] = __builtin_amdgcn_mfma_f32_16x16x32_bf16(Bt[n][k], At[m][k], acc[ai][bj][m][n], 0, 0, 0); __builtin_amdgcn_s_setprio(0); } while (0)
#define PG8_WAIT_V(n) asm volatile("s_waitcnt vmcnt(" #n ")" ::: "memory")
#define PG8_WAIT_L(n) asm volatile("s_waitcnt lgkmcnt(" #n ")" ::: "memory")
#define PG8_BAR __builtin_amdgcn_s_barrier()
#define PG8_SCHED __builtin_amdgcn_sched_barrier(0)
    Unit cur, nxt; int ui = 0;
    if (!S.next(0, cur)) return;
    f32x4 acc[2][2][4][2];
#pragma unroll
    for (int a = 0; a < 2; ++a)
#pragma unroll
        for (int b = 0; b < 2; ++b)
#pragma unroll
            for (int m = 0; m < 4; ++m)
#pragma unroll
                for (int n = 0; n < 2; ++n) acc[a][b][m][n] = (f32x4){0.f, 0.f, 0.f, 0.f};
    bf16x8 At[4][2], B0[2][2], B1[2][2];
    const char* cA = (const char*)g.A + (size_t)cur.pm * tstepA; const char* cB = (const char*)g.Bt + (size_t)cur.pn * tstep;
    S.a_ready(cur);
    if constexpr (SP2) {
        PG8_STAGE(PG8_SB(0, 0), cB, voffB); PG8_STAGE(PG8_SB(0, 1), cB + hstep, voffB); PG8_STAGE(PG8_SA(0, 0), cA, voffA); PG8_STAGE(PG8_SA(0, 1), cA + hstepA, voffA1);
        if (wr == 1) PG8_BAR;
        PG8_WAIT_V(2); PG8_BAR;
        PG8_STAGE(PG8_SB(1, 0), cB + kstep, voffB); PG8_STAGE(PG8_SA(1, 0), cA + kstep, voffA); PG8_STAGE(PG8_SB(1, 1), cB + hstep + kstep, voffB);
        PG8_WAIT_V(6); PG8_BAR;
    } else {
        PG8_STAGE(PG8_SB(0, 0), cB, voffB); PG8_STAGE(PG8_SA(0, 0), cA, voffA); PG8_STAGE(PG8_SB(0, 1), cB + hstep, voffB); PG8_STAGE(PG8_SA(0, 1), cA + hstepA, voffA1);
        if (wr == 1) PG8_BAR;
        PG8_WAIT_V(4); PG8_BAR;
        PG8_STAGE(PG8_SB(1, 0), cB + kstep, voffB); PG8_STAGE(PG8_SA(1, 0), cA + kstep, voffA); PG8_STAGE(PG8_SB(1, 1), cB + hstep + kstep, voffB);
        PG8_WAIT_V(6); PG8_BAR;
    }
    for (;;) {
        const bool has_next = S.next(ui + 1, nxt);
        const char* nA = has_next ? (const char*)g.A + (size_t)nxt.pm * tstepA : cA; const char* nB = has_next ? (const char*)g.Bt + (size_t)nxt.pn * tstep : cB;
#pragma nounroll
        for (int t = 0; t < nt; t += 2) {
            const bool last = (t == nt - 2);
            const char* a1 = cA + (size_t)(t + 1) * kstep;
            const char* a2 = last ? nA : cA + (size_t)(t + 2) * kstep; const char* b2 = last ? nB : cB + (size_t)(t + 2) * kstep;
            const char* a3 = a2 + kstep; const char* b3 = b2 + kstep;
            if (last && has_next) S.a_ready(nxt);
            if constexpr (SP2) {
            PG8_LDB(B0, 0, 0); PG8_LDB(B1, 0, 1); PG8_SCHED; PG8_LDA(At, 0, 0); PG8_STAGE(PG8_SA(1, 1), a1 + hstepA, voffA1);
            PG8_WAIT_V(8); PG8_WAIT_L(0); PG8_BAR; PG8_MMA(0, 0, At, B0); PG8_MMA(0, 1, At, B1); PG8_BAR; PG8_SCHED;
            if (!HALFM) PG8_LDA(At, 0, 1); PG8_STAGE(PG8_SB(0, 0), b2, voffB); PG8_STAGE(PG8_SB(0, 1), b2 + hstep, voffB); PG8_STAGE(PG8_SA(0, 0), a2, voffA);
            PG8_WAIT_V(8); PG8_WAIT_L(0); PG8_BAR; if (!HALFM) { PG8_MMA(1, 0, At, B0); PG8_MMA(1, 1, At, B1); } PG8_BAR; PG8_SCHED;
            PG8_LDB(B0, 1, 0); PG8_LDB(B1, 1, 1); PG8_SCHED; PG8_LDA(At, 1, 0); PG8_STAGE(PG8_SA(0, 1), a2 + hstepA, voffA1);
            PG8_WAIT_V(8); PG8_WAIT_L(0); PG8_BAR; PG8_MMA(0, 0, At, B0); PG8_MMA(0, 1, At, B1); PG8_BAR; PG8_SCHED;
            if (!HALFM) PG8_LDA(At, 1, 1); PG8_STAGE(PG8_SB(1, 0), b3, voffB); PG8_STAGE(PG8_SB(1, 1), b3 + hstep, voffB); PG8_STAGE(PG8_SA(1, 0), a3, voffA);
            PG8_WAIT_V(8); PG8_WAIT_L(0); PG8_BAR; if (!HALFM) { PG8_MMA(1, 0, At, B0); PG8_MMA(1, 1, At, B1); } PG8_BAR; PG8_SCHED;
            } else {
            PG8_LDB(B0, 0, 0); PG8_SCHED; PG8_LDA(At, 0, 0); PG8_STAGE(PG8_SA(1, 1), a1 + hstepA, voffA1);
            PG8_WAIT_L(8); PG8_BAR; PG8_WAIT_L(0); PG8_MMA(0, 0, At, B0); PG8_BAR; PG8_SCHED;
            PG8_LDB(B1, 0, 1); PG8_STAGE(PG8_SB(0, 0), b2, voffB);
            PG8_BAR; PG8_WAIT_L(0); PG8_MMA(0, 1, At, B1); PG8_BAR;
            PG8_LDA(At, 0, 1); PG8_STAGE(PG8_SA(0, 0), a2, voffA);
            PG8_BAR; PG8_WAIT_L(0); PG8_MMA(1, 0, At, B0); PG8_BAR; PG8_SCHED;
            PG8_STAGE(PG8_SB(0, 1), b2 + hstep, voffB);
            PG8_WAIT_V(6); PG8_BAR; PG8_MMA(1, 1, At, B1); PG8_BAR;
            PG8_LDB(B0, 1, 0); PG8_SCHED; PG8_LDA(At, 1, 0); PG8_STAGE(PG8_SA(0, 1), a2 + hstepA, voffA1);
            PG8_WAIT_L(8); PG8_BAR; PG8_WAIT_L(0); PG8_MMA(0, 0, At, B0); PG8_BAR; PG8_SCHED;
            PG8_LDB(B1, 1, 1); PG8_STAGE(PG8_SB(1, 0), b3, voffB);
            PG8_BAR; PG8_WAIT_L(0); PG8_MMA(0, 1, At, B1); PG8_BAR;
            PG8_LDA(At, 1, 1); PG8_STAGE(PG8_SA(1, 0), a3, voffA);
            PG8_BAR; PG8_WAIT_L(0); PG8_MMA(1, 0, At, B0); PG8_BAR; PG8_SCHED;
            PG8_STAGE(PG8_SB(1, 1), b3 + hstep, voffB);
            PG8_WAIT_V(6); PG8_BAR; PG8_MMA(1, 1, At, B1); PG8_BAR;
            }
        }
        if constexpr (ALIGN_EPI) { if (wr == 0) PG8_BAR; }
        if constexpr (!Epi::AFTER_DRAIN) { E(acc, cur, wr, wc, fr, fq); S.done(cur); }
        if (!has_next) break;
#pragma unroll
        for (int a = 0; a < 2; ++a)
#pragma unroll
            for (int b = 0; b < 2; ++b)
#pragma unroll
                for (int m = 0; m < 4; ++m)
#pragma unroll
                    for (int n = 0; n < 2; ++n) acc[a][b][m][n] = (f32x4){0.f, 0.f, 0.f, 0.f};
        cur = nxt; cA = nA; cB = nB; ++ui;
        if constexpr (ALIGN_EPI) { if (wr == 1) PG8_BAR; }
    }
    PG8_WAIT_V(0);
    if constexpr (!ALIGN_EPI) { if (wr == 0) PG8_BAR; }
    PG8_BAR;
    if constexpr (Epi::AFTER_DRAIN) { E.fused(acc, cur, wr, wc, fr, fq, lds, wid, lane); S.done(cur); }
#undef PG8_SA
#undef PG8_SB
#undef PG8_STAGE
#undef PG8_LDA
#undef PG8_LDB
#undef PG8_MMA
#undef PG8_WAIT_V
#undef PG8_WAIT_L
#undef PG8_BAR
#undef PG8_SCHED
}

typedef int i32x4 __attribute__((ext_vector_type(4)));
struct MoeStream {
    const unsigned char* h2q; const unsigned char* wgu8; const float* swgu; bf16_t* hid; const unsigned char* hidq; const unsigned char* wd8; const float* swd; unsigned char* y;
    const PG8_LAS unsigned short* texp;
    const PG8_LAS unsigned short* glist;
    const PG8_LAS float* rscale;
    const PG8_LAS unsigned short* tl;
    const PG8_LAS unsigned short* rl;
    int n;
    const PG8_LAS int* dst;
    const PG8_LAS float* lsc;
    StaticOrder order;
};
struct MUnit { int kind, slot, tile, j, e, rows; };
template <int KIND> __device__ __forceinline__ bool moe_next(const MoeStream& S, int q, MUnit& u) {
    if (KIND == 2) { Unit uu; if (!S.order.next(q, uu)) return false; u.kind = 2; u.slot = 0; u.tile = uu.pm; u.j = uu.pn; u.e = 0; u.rows = 256; return true; }
    if (KIND == 0) { if (q >= 2 * S.n) return false; u.kind = 0; u.slot = q >> 1; u.j = q & 1; }
    else { if (q >= 4 * S.n) return false; u.kind = 1; u.slot = q >> 2; u.j = q & 3; }
    u.tile = __builtin_amdgcn_readfirstlane((int)S.tl[u.slot]); u.rows = __builtin_amdgcn_readfirstlane((int)S.rl[u.slot]); u.e = __builtin_amdgcn_readfirstlane((int)S.texp[u.tile]); return true;
}
template <int KIND, int VAR = 0> __device__ __forceinline__ void moe_stream(PG8_LAS unsigned char* lds, const MoeStream S) {
    int tid_ = threadIdx.x; asm volatile("" : "+v"(tid_));
    const int tid = tid_, wid = __builtin_amdgcn_readfirstlane(tid >> 6), lane = tid & 63, wr = wid >> 2, wc = wid & 3, fr = lane & 15, fq = lane >> 4;
    unsigned voffA[2], voffA1[2], voffB[2];
#define MS_OFFS(u) do { int tidv_ = tid; asm volatile("" : "+v"(tidv_)); _Pragma("unroll") for (int i_ = 0; i_ < 2; ++i_) { int sR[2], sC[2], sRb[2]; stage_rc(tidv_ * 16 + i_ * 8192, sR[i_], sC[i_]); sRb[i_] = (sR[i_] & ~31) + perm32(sR[i_] & 31); \
        if (KIND == 2) { voffA[i_] = (unsigned)(sR[i_] * 1024 + sC[i_] * 2); voffA1[i_] = voffA[i_]; voffB[i_] = (unsigned)(sRb[i_] * 1024 + sC[i_] * 2); } \
        else if (KIND == 0) { const PG8_LAS unsigned short* gl_ = S.glist + (u).slot * 256; \
            voffA[i_] = (unsigned)((int)gl_[sR[i_]] * 1024 + sC[i_] * 2); voffA1[i_] = (unsigned)((int)gl_[HALF + sR[i_]] * 1024 + sC[i_] * 2); voffB[i_] = (unsigned)(sRb[i_] * 1024 + sC[i_] * 2); } \
        else { voffA[i_] = (unsigned)(sR[i_] * 256 + sC[i_] * 2); voffA1[i_] = voffA[i_]; voffB[i_] = (unsigned)(sRb[i_] * 256 + sC[i_] * 2); } } } while (0)
#define MS_PARAMS(u, pA, pB, hA, hB, ntv) do { \
        if (KIND == 2) { pA = (const char*)S.h2q + (size_t)(u).tile * (256 * 1024); hA = (unsigned)(HALF * 1024); pB = (const char*)S.wgu8 + (size_t)(u).j * (256 * 1024); hB = (unsigned)(HALF * 1024); ntv = 8; } \
        else if (KIND == 0) { pA = (const char*)S.h2q; hA = 0u; pB = (const char*)S.wgu8 + (size_t)((u).e * 2 + (u).j) * (256 * 1024); hB = (unsigned)(HALF * 1024); ntv = 8; } \
        else { pA = (const char*)S.hidq + (size_t)(u).tile * (256 * 256); hA = (unsigned)(HALF * 256); pB = (const char*)S.wd8 + (size_t)((u).e * 4 + (u).j) * (256 * 256); hB = (unsigned)(HALF * 256); ntv = 2; } } while (0)
    const size_t kstep = (size_t)(BK * 2);
    const unsigned ldsw = (unsigned)wid * 1024u;
    const int aoff = lds_byte(wr * 64 + fr, fq * 8), boff = lds_byte(wc * 32 + fr, fq * 8);
#define PG8_SA(b, h) (((b) * 2 + (h)) * HTB)
#define PG8_SB(b, h) ((4 + (b) * 2 + (h)) * HTB)
#define PG8_STAGE(bufoff, gbase, voff) do { _Pragma("unroll") for (int _i = 0; _i < 2; ++_i) { unsigned vo_ = (voff)[_i]; asm volatile("" : "+v"(vo_));     \
        __builtin_amdgcn_global_load_lds((const unsigned*)((const char*)(gbase) + vo_), (PG8_LAS unsigned*)(lds + (bufoff) + ldsw + _i * 8192), 16, 0, 0); } } while (0)
#define PG8_LDA(dst, b, h) do { _Pragma("unroll") for (int m = 0; m < 4; ++m) _Pragma("unroll") for (int k = 0; k < 2; ++k) dst[m][k] = *(const PG8_LAS bf16x8*)(lds + PG8_SA(b, h) + aoff + m * 2048 + k * 1024); } while (0)
#define PG8_LDB(dst, b, h) do { _Pragma("unroll") for (int n = 0; n < 2; ++n) _Pragma("unroll") for (int k = 0; k < 2; ++k) dst[n][k] = *(const PG8_LAS bf16x8*)(lds + PG8_SB(b, h) + boff + n * 2048 + k * 1024); } while (0)
#define PG8_MMA(ai, bj, At, Bt) do { __builtin_amdgcn_s_setprio(1); _Pragma("unroll") for (int m = 0; m < 4; ++m) _Pragma("unroll") for (int n = 0; n < 2; ++n) _Pragma("unroll") for (int k = 0; k < 2; ++k) \
        acc[ai][bj][m][n] = __builtin_amdgcn_mfma_f32_16x16x32_bf16(Bt[n][k], At[m][k], acc[ai][bj][m][n], 0, 0, 0); __builtin_amdgcn_s_setprio(0); } while (0)
#define PG8_MMA8(ai, bj, At, Bt) do { __builtin_amdgcn_s_setprio(1); _Pragma("unroll") for (int m = 0; m < 4; ++m) _Pragma("unroll") for (int n = 0; n < 2; ++n) _Pragma("unroll") for (int k = 0; k < 2; ++k) \
        acc[ai][bj][m][n] = __builtin_bit_cast(f32x4, __builtin_amdgcn_mfma_i32_16x16x64_i8(__builtin_bit_cast(i32x4, Bt[n][k]), __builtin_bit_cast(i32x4, At[m][k]), __builtin_bit_cast(i32x4, acc[ai][bj][m][n]), 0, 0, 0)); __builtin_amdgcn_s_setprio(0); } while (0)
#define MS_MMA(ai, bj, At, Bt) PG8_MMA8(ai, bj, At, Bt)
#define PG8_WAIT_V(n) asm volatile("s_waitcnt vmcnt(" #n ")" ::: "memory")
#define MS_WAIT_K do { if (KIND == 1) PG8_WAIT_V(4); else PG8_WAIT_V(8); } while (0)
#define PG8_WAIT_L(n) asm volatile("s_waitcnt lgkmcnt(" #n ")" ::: "memory")
#define PG8_BAR __builtin_amdgcn_s_barrier()
#define PG8_SCHED __builtin_amdgcn_sched_barrier(0)
    MUnit cur, nxt; int ui = 0;
    if (!moe_next<KIND>(S, 0, cur)) return;
    f32x4 acc[2][2][4][2];
#pragma unroll
    for (int a = 0; a < 2; ++a)
#pragma unroll
        for (int b = 0; b < 2; ++b)
#pragma unroll
            for (int m = 0; m < 4; ++m)
#pragma unroll
                for (int n = 0; n < 2; ++n) acc[a][b][m][n] = (f32x4){0.f, 0.f, 0.f, 0.f};
    bf16x8 At[4][2], B0[2][2], B1[2][2];
    const char* cA; const char* cB; unsigned chA, chB; int nt;
    MS_PARAMS(cur, cA, cB, chA, chB, nt);
    asm volatile("" : "+s"(nt));
    MS_OFFS(cur);
    PG8_STAGE(PG8_SB(0, 0), cB, voffB); PG8_STAGE(PG8_SB(0, 1), cB + chB, voffB); PG8_STAGE(PG8_SA(0, 0), cA, voffA); PG8_STAGE(PG8_SA(0, 1), cA + chA, voffA1);
    if (wr == 1) PG8_BAR;
    PG8_WAIT_V(2); PG8_BAR;
    PG8_STAGE(PG8_SB(1, 0), cB + kstep, voffB); PG8_STAGE(PG8_SA(1, 0), cA + kstep, voffA); PG8_STAGE(PG8_SB(1, 1), cB + chB + kstep, voffB);
    PG8_WAIT_V(6); PG8_BAR;
    for (;;) {
        const bool has_next = moe_next<KIND>(S, ui + 1, nxt);
        const char* nA = cA; const char* nB = cB; unsigned nhA = chA, nhB = chB; int nnt = nt;
        if (has_next) MS_PARAMS(nxt, nA, nB, nhA, nhB, nnt);
        const bool new_offs = KIND != 2 && has_next && (nxt.kind != cur.kind || nxt.slot != cur.slot);
        const bool stA_cur = KIND != 1 || cur.j == 0, stA_nxt = KIND != 1 || (has_next && nxt.j == 0);
        const bool act0 = VAR != 3 && (KIND == 2 || cur.rows > 64 * wr), act1 = VAR != 3 && (KIND == 2 || cur.rows > 128 + 64 * wr);
#pragma nounroll
        for (int t = 0; t < nt; t += 2) {
            const bool last = (t == nt - 2);
            const char* a1 = cA + (size_t)(t + 1) * kstep;
            const char* a2 = last ? nA : cA + (size_t)(t + 2) * kstep; const char* b2 = last ? nB : cB + (size_t)(t + 2) * kstep;
            const char* a3 = a2 + kstep; const char* b3 = b2 + kstep;
            const unsigned hA2 = last ? nhA : chA, hB2 = last ? nhB : chB;
            if (act0) { PG8_LDB(B0, 0, 0); PG8_LDB(B1, 0, 1); PG8_SCHED; PG8_LDA(At, 0, 0); } if (stA_cur) PG8_STAGE(PG8_SA(1, 1), a1 + chA, voffA1);
            if (last && new_offs) MS_OFFS(nxt);
            MS_WAIT_K; PG8_WAIT_L(0); PG8_BAR; if (act0) { MS_MMA(0, 0, At, B0); MS_MMA(0, 1, At, B1); } PG8_BAR; PG8_SCHED;
            if (act1) PG8_LDA(At, 0, 1); PG8_STAGE(PG8_SB(0, 0), b2, voffB); PG8_STAGE(PG8_SB(0, 1), b2 + hB2, voffB); if (stA_nxt) PG8_STAGE(PG8_SA(0, 0), a2, voffA);
            MS_WAIT_K; PG8_WAIT_L(0); PG8_BAR; if (act1) { MS_MMA(1, 0, At, B0); MS_MMA(1, 1, At, B1); } PG8_BAR; PG8_SCHED;
            if (act0) { PG8_LDB(B0, 1, 0); PG8_LDB(B1, 1, 1); PG8_SCHED; PG8_LDA(At, 1, 0); } if (stA_nxt) PG8_STAGE(PG8_SA(0, 1), a2 + hA2, voffA1);
            MS_WAIT_K; PG8_WAIT_L(0); PG8_BAR; if (act0) { MS_MMA(0, 0, At, B0); MS_MMA(0, 1, At, B1); } PG8_BAR; PG8_SCHED;
            if (act1) PG8_LDA(At, 1, 1); PG8_STAGE(PG8_SB(1, 0), b3, voffB); PG8_STAGE(PG8_SB(1, 1), b3 + hB2, voffB); if (stA_nxt) PG8_STAGE(PG8_SA(1, 0), a3, voffA);
            MS_WAIT_K; PG8_WAIT_L(0); PG8_BAR; if (act1) { MS_MMA(1, 0, At, B0); MS_MMA(1, 1, At, B1); } PG8_BAR; PG8_SCHED;
        }
        if (wr == 0) PG8_BAR;
        if constexpr (KIND == 2) {
            const int ncols = S.order.nN * BM;
            const float* swp = S.swgu + cur.j * BM + wc * 32 + 8 * fq;
            f32x4 sw[2][2];
#pragma unroll
            for (int bj = 0; bj < 2; ++bj)
#pragma unroll
                for (int n = 0; n < 2; ++n) sw[bj][n] = *(const f32x4*)(swp + bj * HALF + 4 * n);
            const float* rsg = S.swd + cur.tile * BM + wr * 64 + fr;
            bf16_t* orow = S.hid + (size_t)(cur.tile * BM + wr * 64 + fr) * ncols + cur.j * BM + wc * 32 + 8 * fq;
#pragma unroll
            for (int ai = 0; ai < 2; ++ai)
#pragma unroll
                for (int m = 0; m < 4; ++m) { const float rs = rsg[ai * HALF + m * 16];
#pragma unroll
                    for (int bj = 0; bj < 2; ++bj) { const i32x4 i0 = __builtin_bit_cast(i32x4, acc[ai][bj][m][0]), i1 = __builtin_bit_cast(i32x4, acc[ai][bj][m][1]); f32x4 v0, v1;
#pragma unroll
                        for (int e4 = 0; e4 < 4; ++e4) { v0[e4] = (float)i0[e4] * (rs * sw[bj][0][e4]); v1[e4] = (float)i1[e4] * (rs * sw[bj][1][e4]); }
                        *(u32x4*)(orow + (size_t)(ai * HALF + m * 16) * ncols + bj * HALF) = pack8(v0, v1); }
                    asm volatile("" ::: "memory"); }
        } else if constexpr (VAR >= 2) {
            if (VAR == 2) {
#pragma unroll
                for (int a_ = 0; a_ < 2; ++a_)
#pragma unroll
                    for (int b_ = 0; b_ < 2; ++b_)
#pragma unroll
                        for (int m_ = 0; m_ < 4; ++m_)
#pragma unroll
                            for (int n_ = 0; n_ < 2; ++n_) asm volatile("" :: "v"(acc[a_][b_][m_][n_])); }
        } else if constexpr (KIND == 0) {
            const PG8_LAS float* swp = S.lsc + cur.slot * 512 + cur.j * 256 + wc * 32 + 8 * fq;
            const f32x4 sg0 = *(const PG8_LAS f32x4*)swp, sg1 = *(const PG8_LAS f32x4*)(swp + 4), su0 = *(const PG8_LAS f32x4*)(swp + HALF), su1 = *(const PG8_LAS f32x4*)(swp + HALF + 4);
            asm volatile("" :: "v"(sg0), "v"(sg1), "v"(su0), "v"(su1));
            const PG8_LAS float* rsp = S.rscale + cur.slot * 256 + wr * 64 + fr;
            bf16_t* hrow = S.hid + (size_t)(cur.tile * BM + wr * 64 + fr) * 256 + 128 * cur.j + wc * 32 + 8 * fq;
#pragma unroll
            for (int ai = 0; ai < 2; ++ai)
#pragma unroll
                for (int m = 0; m < 4; ++m) { if (cur.rows <= ai * HALF + wr * 64 + m * 16) continue;
                    const float rs = rsp[ai * HALF + m * 16]; f32x4 h0, h1;
                    { const i32x4 gi = __builtin_bit_cast(i32x4, acc[ai][0][m][0]), ui = __builtin_bit_cast(i32x4, acc[ai][1][m][0]);
#pragma unroll
                        for (int e4 = 0; e4 < 4; ++e4) h0[e4] = silu_f((float)gi[e4] * (rs * sg0[e4])) * ((float)ui[e4] * (rs * su0[e4])); }
                    { const i32x4 gi = __builtin_bit_cast(i32x4, acc[ai][0][m][1]), ui = __builtin_bit_cast(i32x4, acc[ai][1][m][1]);
#pragma unroll
                        for (int e4 = 0; e4 < 4; ++e4) h1[e4] = silu_f((float)gi[e4] * (rs * sg1[e4])) * ((float)ui[e4] * (rs * su1[e4])); }
                    if (VAR == 0) *(u32x4*)(hrow + (size_t)(ai * HALF + m * 16) * 256) = pack8(h0, h1); else { u32x4 pk_ = pack8(h0, h1); asm volatile("" :: "v"(pk_)); } asm volatile("" ::: "memory"); }
        }
        else {
            const float swv = S.lsc[cur.slot * 8 + cur.j * 2 + (wc >> 1)];
            asm volatile("" :: "v"(swv));
            const PG8_LAS float* rsp = S.rscale + cur.slot * 256 + wr * 64 + fr;
            unsigned char* ycol = S.y + cur.j * BM + wc * 64 + 16 * fq; const PG8_LAS int* dsp = S.dst + cur.slot * 256 + wr * 64 + fr;
#pragma unroll
            for (int ai = 0; ai < 2; ++ai)
#pragma unroll
                for (int m = 0; m < 4; ++m) { if (cur.rows <= ai * HALF + wr * 64 + m * 16) continue;
                    const float rs = rsp[ai * HALF + m * 16] * swv; u32x4 w;
#pragma unroll
                    for (int bj = 0; bj < 2; ++bj)
#pragma unroll
                        for (int n = 0; n < 2; ++n) { const i32x4 vi = __builtin_bit_cast(i32x4, acc[ai][bj][m][n]);
                            int t = __builtin_amdgcn_cvt_pk_fp8_f32((float)vi[0] * rs, (float)vi[1] * rs, 0, false); t = __builtin_amdgcn_cvt_pk_fp8_f32((float)vi[2] * rs, (float)vi[3] * rs, t, true); w[2 * bj + n] = (unsigned)t; }
                    const int d_ = dsp[ai * HALF + m * 16]; if (VAR == 0) { if (d_ >= 0) *(u32x4*)(ycol + (size_t)d_ * 1024) = w; } else asm volatile("" :: "v"(w), "v"(d_)); asm volatile("" ::: "memory"); }
        }
        if (!has_next) break;
#pragma unroll
        for (int a = 0; a < 2; ++a)
#pragma unroll
            for (int b = 0; b < 2; ++b)
#pragma unroll
                for (int m = 0; m < 4; ++m)
#pragma unroll
                    for (int n = 0; n < 2; ++n) acc[a][b][m][n] = (f32x4){0.f, 0.f, 0.f, 0.f};
        cur = nxt; cA = nA; cB = nB; chA = nhA; chB = nhB; nt = nnt; ++ui;
        if (wr == 1) PG8_BAR;
    }
    PG8_WAIT_V(0);
    PG8_BAR;
#undef MS_OFFS
#undef MS_WAIT_K
#undef MS_MMA
#undef PG8_MMA8
#undef MS_PARAMS
#undef PG8_SA
#undef PG8_SB
#undef PG8_STAGE
#undef PG8_LDA
#undef PG8_LDB
#undef PG8_MMA
#undef PG8_WAIT_V
#undef PG8_WAIT_L
#undef PG8_BAR
#undef PG8_SCHED
}


}

#ifndef MK_MULTI
#define MK_MULTI 0
#endif
constexpr int NWAVES = 8, NTHR = 512;
constexpr int D = 1024, NB = 8, SEQ = 4096, T = NB * SEQ;
constexpr int QC = 512, KVC = 128, CC = 512, INC = 1792;
constexpr int NE = 256, TOPK = 8, EH = 256, CW = 31;
constexpr int NEX = NE + 1;
constexpr int NSLOT = TOPK + 1;
constexpr int PMAX = T * TOPK + T + NEX * 256;
constexpr int MAXTILES = PMAX / 256;
constexpr float EPS = 1e-6f;
constexpr int NPHASE = 12;
constexpr size_t MiB = 1u << 20;
constexpr size_t WS_CTL = 0, CTL_ZERO_BYTES = 1 * MiB;
constexpr size_t WS_MOD = 1 * MiB;
constexpr size_t WS_ROWTOK = 2 * MiB, WS_ROWDST = WS_ROWTOK + (size_t)PMAX * 4, WS_ROWW = WS_ROWDST + (size_t)PMAX * 4;
constexpr size_t WS_EIDX = 6 * MiB, WS_GW = 7 * MiB, WS_POS = 8 * MiB;
constexpr size_t WS_WIN = 10 * MiB;
constexpr size_t WS_WOUT = 14 * MiB;
constexpr size_t WS_WRS = 16 * MiB;
constexpr size_t WS_WSHD = 18 * MiB;
constexpr size_t WS_WD = 20 * MiB;
constexpr size_t WS_LOGITS = 148 * MiB;
constexpr size_t WS_HIDSH = 180 * MiB;
constexpr size_t WS_HID = 148 * MiB;
constexpr size_t WS_H = 356 * MiB;
constexpr size_t WS_WGU = 420 * MiB;
constexpr size_t WS_H2Q = 549 * MiB;
constexpr size_t WS_SWGU = 2 * MiB;
constexpr size_t WS_SA = 3 * MiB;
constexpr size_t WS_WSHQ = 5 * MiB;
constexpr size_t WS_SWSH = 4 * MiB + 65536;
constexpr size_t WS_WINQ = 10 * MiB;
constexpr size_t WS_SWIN = 4 * MiB + 131072;
constexpr size_t WS_SA1 = 3 * MiB + 262144;
constexpr size_t WS_SWD = 4 * MiB;
constexpr size_t WS_HIDQ = 581 * MiB;
constexpr size_t WS_Y = 676 * MiB;
constexpr size_t WS_PROJ = 676 * MiB;
constexpr size_t WS_CAT = 788 * MiB;
constexpr size_t WS_LIST = 996 * MiB;
constexpr size_t WS_SLOT = 1012 * MiB;
constexpr size_t WS_END = 1020 * MiB;
static_assert(WS_HID + (size_t)PMAX * 512 <= WS_H && WS_LOGITS >= WS_WD + (size_t)NEX * 1024 * 256 && WS_H + (size_t)T * D * 2 <= WS_WGU && WS_WGU + (size_t)NEX * 512 * 1024 <= WS_H2Q && WS_H2Q + (size_t)T * D <= WS_HIDQ && WS_HIDQ + (size_t)PMAX * 256 <= WS_Y && WS_Y + (size_t)(T * NSLOT + 1) * 1024 <= WS_LIST && WS_LIST + (size_t)NE * T * 2 <= WS_SLOT && WS_SLOT + (size_t)NE * T <= WS_END && WS_PROJ + (size_t)T * INC * 2 <= WS_END, "d_ws map");
constexpr size_t WS_NEED = WS_END;
constexpr int CW_BAR = 4096;
constexpr int CW_COUNTS = 8192;
constexpr int CW_PANEL = 32768;
constexpr int CW_SHQ = 1024;
constexpr int RING_BYTES = 131072;
constexpr int LX_MISC = RING_BYTES;
constexpr int LX_BASE = RING_BYTES + 256;
constexpr int LX_TEXP = LX_BASE + 1040;
constexpr int LX_CNT = LX_TEXP + 2880;
constexpr int LX_GL = LX_CNT + 1040;
constexpr int LX_RS = LX_GL + 6 * 512;
constexpr int LX_DST = LX_RS + 6 * 1024;
constexpr int LX_MY = LX_DST + 6 * 2048;
constexpr int LX_FT = LX_MY + 256;
constexpr int LX_CT = LX_FT + 2880;
constexpr int LDS_BYTES = 161792;
static_assert(LX_CT + 528 <= LDS_BYTES, "LDS map");

#define GAS __attribute__((address_space(1)))
#define LAS __attribute__((address_space(3)))
typedef unsigned short bf16;
typedef unsigned v4u __attribute__((ext_vector_type(4)));
typedef unsigned v2u __attribute__((ext_vector_type(2)));
typedef float f32x4 __attribute__((ext_vector_type(4)));
typedef float f32x16 __attribute__((ext_vector_type(16)));
typedef short bf16x8 __attribute__((ext_vector_type(8)));
typedef short s16x4 __attribute__((ext_vector_type(4)));
typedef GAS unsigned gu32;
#define RLX_AGENT __ATOMIC_RELAXED, __HIP_MEMORY_SCOPE_AGENT
using pg8::pkbf; using pg8::silu_f;
__device__ __forceinline__ float bf2f(unsigned short b) { return __uint_as_float((unsigned)b << 16); }
__device__ __forceinline__ float bflo(unsigned w) { return __uint_as_float(w << 16); }
__device__ __forceinline__ float bfhi(unsigned w) { return __uint_as_float(w & 0xffff0000u); }

#define XB_TMO      128
#define XB_XCNT(j)  (256  + 64 * (j))
#define XB_XSUB(j)  (1280 + 64 * (j))
#define XB_XGEN(j)  (2304 + 64 * (j))
#define XB_TOP      3328
#define XB_TOPGEN   3392
#define XCD_BAR_WORDS 3456
#define XB_SPIN_CAP (1u << 22)
__device__ __forceinline__ unsigned xb_ld(unsigned* p)              { return __hip_atomic_load(p, __ATOMIC_RELAXED, __HIP_MEMORY_SCOPE_AGENT); }
__device__ __forceinline__ unsigned xb_add(unsigned* p, unsigned v) { return __hip_atomic_fetch_add(p, v, __ATOMIC_RELAXED, __HIP_MEMORY_SCOPE_AGENT); }
__device__ __forceinline__ unsigned xb_xcc_id() { return (unsigned)__builtin_amdgcn_s_getreg((3 << 11) | 20) & 0xFu; }
#define XB_SPIN(cond, bar) do { unsigned _sp = 0; while (cond) { __builtin_amdgcn_s_sleep(1); \
    if ((++_sp & 255u) == 0u) { if (xb_ld(&(bar)[XB_TMO])) break; if (_sp > XB_SPIN_CAP) { atomicAdd(&(bar)[XB_TMO], 1u); break; } } } } while (0)
struct XcdBarrier { unsigned* bar; unsigned x; volatile LAS unsigned* st; };
__device__ __forceinline__ XcdBarrier xcd_barrier_post(unsigned* bar, volatile LAS unsigned* st) {
    XcdBarrier b; b.bar = bar; b.x = xb_xcc_id(); b.st = st;
    if (threadIdx.x == 0) (void)xb_add(&bar[XB_XCNT(b.x)], 1u);
    return b;
}
__device__ __forceinline__ void xcd_barrier_complete(unsigned* bar, unsigned x, unsigned& nloc, unsigned& nx) {
    const unsigned G = gridDim.x * gridDim.y * gridDim.z;
    unsigned sum, cnt, mine, sp = 0u;
    for (;;) {
        sum = 0u; cnt = 0u; mine = 0u;
#pragma unroll
        for (unsigned j = 0; j < 16; ++j) { const unsigned c = xb_ld(&bar[XB_XCNT(j)]); sum += c; cnt += (c > 0u) ? 1u : 0u; mine = (j == x) ? c : mine; }
        if (sum == G) break;
        __builtin_amdgcn_s_sleep(1);
        if ((++sp & 255u) == 0u) { if (xb_ld(&bar[XB_TMO])) break; if (sp > XB_SPIN_CAP) { atomicAdd(&bar[XB_TMO], 1u); break; } }
    }
    nloc = mine > 0u ? mine : 1u; nx = cnt > 0u ? cnt : 1u;
}
__device__ __forceinline__ void xcd_barrier(const XcdBarrier& b) {
    asm volatile("s_waitcnt vmcnt(0)" ::: "memory");
    __syncthreads();
    if (threadIdx.x == 0) {
        unsigned* bar = b.bar;
        __builtin_amdgcn_s_waitcnt(0);
        unsigned nloc = b.st[0], nx = b.st[1];
        if (nloc == 0u) { xcd_barrier_complete(bar, b.x, nloc, nx); b.st[0] = nloc; b.st[1] = nx; }
        const unsigned old = xb_add(&bar[XB_XSUB(b.x)], 1u);
        const unsigned gen = old / nloc;
        if (old + 1u == (gen + 1u) * nloc) {
            __builtin_amdgcn_fence(__ATOMIC_RELEASE, "agent");
            asm volatile("s_waitcnt vmcnt(0)" ::: "memory");
            const unsigned og = xb_add(&bar[XB_TOP], 1u);
            const unsigned tg = og / nx;
            if (og + 1u == (tg + 1u) * nx) xb_add(&bar[XB_TOPGEN], 1u);
            else XB_SPIN(xb_ld(&bar[XB_TOPGEN]) == tg, bar);
            __builtin_amdgcn_fence(__ATOMIC_ACQUIRE, "agent");
            xb_add(&bar[XB_XGEN(b.x)], 1u);
            asm volatile("s_waitcnt vmcnt(0)" ::: "memory");
        } else {
            XB_SPIN(xb_ld(&bar[XB_XGEN(b.x)]) == gen, bar);
            __builtin_amdgcn_fence(__ATOMIC_ACQUIRE, "agent");
            asm volatile("s_waitcnt vmcnt(0)" ::: "memory");
        }
    }
    __syncthreads();
}

#define LDS_WAIT() asm volatile("s_waitcnt lgkmcnt(0)" ::: "memory")
__device__ __forceinline__ float wave_sum(float v) {
#pragma unroll
    for (int o = 1; o < 64; o <<= 1) v += __shfl_xor(v, o);
    return v;
}

__device__ __forceinline__ float wave_max_f(float x) {
    int v = (int)__float_as_uint(x);
#define WMX_STEP(ctrl, rmask) { const int o = __builtin_amdgcn_update_dpp(v, v, ctrl, rmask, 0xf, false); v = (int)__float_as_uint(fmaxf(__uint_as_float((unsigned)v), __uint_as_float((unsigned)o))); }
    WMX_STEP(0xb1, 0xf)
    WMX_STEP(0x4e, 0xf)
    WMX_STEP(0x114, 0xf)
    WMX_STEP(0x118, 0xf)
    WMX_STEP(0x142, 0xa)
    WMX_STEP(0x143, 0xc)
#undef WMX_STEP
    return __uint_as_float((unsigned)__builtin_amdgcn_readlane(v, 63));
}
__device__ __forceinline__ float wave_sum_dpp(float x) {
    int v = (int)__float_as_uint(x);
#define WSM_STEP(ctrl, rmask) { const int o = __builtin_amdgcn_update_dpp(0, v, ctrl, rmask, 0xf, false); v = (int)__float_as_uint(__uint_as_float((unsigned)v) + __uint_as_float((unsigned)o)); }
    WSM_STEP(0xb1, 0xf)
    WSM_STEP(0x4e, 0xf)
    WSM_STEP(0x114, 0xf)
    WSM_STEP(0x118, 0xf)
    WSM_STEP(0x142, 0xa)
    WSM_STEP(0x143, 0xc)
#undef WSM_STEP
    return __uint_as_float((unsigned)__builtin_amdgcn_readlane(v, 63));
}
__device__ __forceinline__ float dpp16_sum(float x) {
    int v = (int)__float_as_uint(x);
#define D8_STEP(ctrl) { const int o = __builtin_amdgcn_update_dpp(v, v, ctrl, 0xf, 0xf, false); v = (int)__float_as_uint(__uint_as_float((unsigned)v) + __uint_as_float((unsigned)o)); }
    D8_STEP(0xb1) D8_STEP(0x4e) D8_STEP(0x141) D8_STEP(0x140)
#undef D8_STEP
    return __uint_as_float((unsigned)v);
}
struct Args { const float* in[22]; float* out; unsigned char* ws; int ph_lo, ph_hi, aux, pad; };
__device__ __forceinline__ const float* inp(int i) {
    typedef const float* cfp;
    const __attribute__((address_space(4))) cfp* ka = (const __attribute__((address_space(4))) cfp*)__builtin_amdgcn_kernarg_segment_ptr();
    return *(const volatile __attribute__((address_space(4))) cfp*)(ka + i);
}

__device__ __forceinline__ void transpose_tile_p(const float* src, int ldsrc, bf16* dst, int ldd, const int (&ro)[4], LAS float* scr, int lane) {
    float tv[32];
#pragma unroll
    for (int i = 0; i < 32; ++i) tv[i] = __builtin_nontemporal_load(src + (size_t)(2 * i + (lane >> 5)) * ldsrc + (lane & 31));
#pragma unroll
    for (int i = 0; i < 32; ++i) scr[(2 * i + (lane >> 5)) * 33 + (lane & 31)] = tv[i];
    LDS_WAIT(); asm volatile("" ::: "memory");
    const int c = lane & 7;
#pragma unroll
    for (int j = 0; j < 4; ++j) { const int n = (lane >> 3) + 8 * j; const LAS float* s = scr + (8 * c) * 33 + n;
        v4u o; o.x = pkbf(s[0 * 33], s[1 * 33]); o.y = pkbf(s[2 * 33], s[3 * 33]); o.z = pkbf(s[4 * 33], s[5 * 33]); o.w = pkbf(s[6 * 33], s[7 * 33]);
        *(GAS v4u*)(dst + (size_t)(ro[j] + (lane >> 3)) * ldd + 8 * c) = o; }
    LDS_WAIT(); asm volatile("" ::: "memory");
}
__device__ __forceinline__ void transpose_tile(const float* src, int ldsrc, bf16* dst, int ldd, LAS float* scr, int lane) {
    float tv[32];
#pragma unroll
    for (int i = 0; i < 32; ++i) tv[i] = __builtin_nontemporal_load(src + (size_t)(2 * i + (lane >> 5)) * ldsrc + (lane & 31));
#pragma unroll
    for (int i = 0; i < 32; ++i) scr[(2 * i + (lane >> 5)) * 33 + (lane & 31)] = tv[i];
    LDS_WAIT(); asm volatile("" ::: "memory");
    const int c = lane & 7;
#pragma unroll
    for (int j = 0; j < 4; ++j) { const int n = (lane >> 3) + 8 * j; const LAS float* s = scr + (8 * c) * 33 + n;
        v4u o; o.x = pkbf(s[0 * 33], s[1 * 33]); o.y = pkbf(s[2 * 33], s[3 * 33]); o.z = pkbf(s[4 * 33], s[5 * 33]); o.w = pkbf(s[6 * 33], s[7 * 33]);
        *(GAS v4u*)(dst + (size_t)n * ldd + 8 * c) = o; }
    LDS_WAIT(); asm volatile("" ::: "memory");
}
__device__ __forceinline__ void p0_phase(const Args& a, LAS unsigned char* lds, int tid, int lane, int wave, int G) {
    unsigned char* ws = a.ws;
    if ((int)blockIdx.x < 192) {
        LAS float* sc = (LAS float*)lds;
        LAS float* red = (LAS float*)(lds + 32768);
        const float* c = inp(1);
        for (int i = tid; i < 8192; i += NTHR) sc[i] = silu_f(c[i]);
        __syncthreads();
        const int cl = tid & 31, ks = tid >> 5, col = blockIdx.x * 32 + cl;
        const float* w = inp(2) + (size_t)(ks * 64) * 6144 + col;
        float acc[8];
#pragma unroll
        for (int b = 0; b < 8; ++b) acc[b] = 0.f;
#pragma unroll 8
        for (int k = 0; k < 64; ++k) { const float wv = w[(size_t)k * 6144];
#pragma unroll
            for (int b = 0; b < 8; ++b) acc[b] += sc[b * 1024 + ks * 64 + k] * wv; }
#pragma unroll
        for (int b = 0; b < 8; ++b) red[(ks * 8 + b) * 32 + cl] = acc[b];
        __syncthreads();
        if (tid < 256) { const int b = tid >> 5; float s = 0.f;
#pragma unroll
            for (int k2 = 0; k2 < 16; ++k2) s += red[(k2 * 8 + b) * 32 + cl];
            ((float*)(ws + WS_MOD))[b * 6144 + col] = s + inp(3)[col]; }
        __syncthreads();
    }
    {
        LAS float* blk = (LAS float*)lds;
        LAS float* pm = (LAS float*)(lds + LX_TEXP);
        LAS float* inv = (LAS float*)(lds + LX_CNT);
        const int n = tid & 31, ks = tid >> 5;
        float tv[64];
        int it = blockIdx.x;
        constexpr int NB1 = (NE + 1) * 16 + INC / 32;
#define B1_DESC(item, SRC, LD, DST, SCL) do { if ((item) < (NE + 1) * 16) { const int e_ = (item) >> 4, up_ = ((item) >> 3) & 1, n0_ = 32 * ((item) & 7); const int dr_ = 256 * (n0_ >> 7) + 128 * up_ + (n0_ & 127); \
                LD = 256; if (e_ < NE) { SRC = inp(15 + up_) + (size_t)e_ * 1024 * 256 + n0_; DST = ws + WS_WGU + (size_t)(e_ * 512 + dr_) * 1024; SCL = (float*)(ws + WS_SWGU) + e_ * 512 + dr_; } \
                else { SRC = inp(18 + up_) + n0_; DST = ws + WS_WGU + (size_t)(NE * 512 + dr_) * 1024; SCL = (float*)(ws + WS_SWGU) + NE * 512 + dr_; } } \
            else { const int n0_ = 32 * ((item) - (NE + 1) * 16); LD = INC; SRC = inp(4) + n0_; DST = ws + WS_WINQ + (size_t)n0_ * 1024; SCL = (float*)(ws + WS_SWIN) + n0_; } } while (0)
#define B1_LOAD(item) do { const float* s0_; int ld_; unsigned char* d0_; float* c0_; B1_DESC(item, s0_, ld_, d0_, c0_); (void)d0_; (void)c0_; const float* sp_ = s0_ + (size_t)(ks * 64) * ld_ + n; \
            _Pragma("unroll") for (int k = 0; k < 64; ++k) tv[k] = __builtin_nontemporal_load(sp_ + (size_t)k * ld_); } while (0)
        if (it < NB1) B1_LOAD(it);
        for (; it < NB1; it += G) {
            const float* src0; int ld0; unsigned char* dst0; float* scl0; B1_DESC(it, src0, ld0, dst0, scl0); (void)src0; (void)ld0;
            float mxv = 0.f;
#pragma unroll
            for (int k = 0; k < 64; ++k) { mxv = fmaxf(mxv, fabsf(tv[k])); blk[(ks * 64 + k) * 32 + n] = tv[k]; }
            pm[ks * 32 + n] = mxv;
            __syncthreads();
            if (it + G < NB1) B1_LOAD(it + G);
            if (tid < 32) { float mx2 = 0.f;
#pragma unroll
                for (int k2 = 0; k2 < 16; ++k2) mx2 = fmaxf(mx2, pm[k2 * 32 + tid]);
                const float sc = mx2 > 0.f ? mx2 * (1.0f / 127.0f) : 1.0f; inv[tid] = 1.0f / sc; scl0[tid] = sc; }
            __syncthreads();
            const float iv = inv[n];
#pragma unroll
            for (int c2 = 0; c2 < 2; ++c2) { const int kc = ks + 16 * c2; const LAS float* s = blk + (32 * kc) * 32 + n;
                unsigned q[8];
#pragma unroll
                for (int w4 = 0; w4 < 8; ++w4) { unsigned pk = 0u;
#pragma unroll
                    for (int b = 0; b < 4; ++b) { int qi = (int)rintf(s[(4 * w4 + b) * 32] * iv); qi = qi > 127 ? 127 : (qi < -127 ? -127 : qi); pk |= ((unsigned)qi & 0xffu) << (8 * b); }
                    q[w4] = pk; }
                unsigned char* dp = dst0 + (size_t)n * 1024 + 32 * kc;
                *(GAS v4u*)dp = (v4u){q[0], q[1], q[2], q[3]}; *(GAS v4u*)(dp + 16) = (v4u){q[4], q[5], q[6], q[7]}; }
            __syncthreads();
        }
#undef B1_LOAD
#undef B1_DESC
        LAS float* pm2 = pm;
        LAS float* inv2 = (LAS float*)(lds + LX_GL);
        const int n2 = tid & 127, ks2 = tid >> 7;
        it = blockIdx.x;
#define B2_LOAD(item) do { const int e_ = (item) >> 3, n0_ = 128 * ((item) & 7); const float* sp_ = (e_ < NE ? inp(17) + (size_t)e_ * 256 * 1024 : inp(20)) + (size_t)(ks2 * 64) * 1024 + n0_ + n2; \
            _Pragma("unroll") for (int k = 0; k < 64; ++k) tv[k] = __builtin_nontemporal_load(sp_ + (size_t)k * 1024); } while (0)
        if (it < NEX * 8) B2_LOAD(it);
        for (; it < NEX * 8; it += G) {
            const int e = it >> 3, n0 = 128 * (it & 7);
            const int cg = n0 + n2, c2 = cg & 255; const int drow = e * 1024 + (cg & ~255) + 128 * ((c2 >> 3) & 1) + 32 * (c2 >> 6) + 8 * ((c2 >> 4) & 3) + (c2 & 7);
            float mxv = 0.f;
#pragma unroll
            for (int k = 0; k < 64; ++k) { mxv = fmaxf(mxv, fabsf(tv[k])); blk[(ks2 * 64 + k) * 128 + n2] = tv[k]; }
            pm2[ks2 * 128 + n2] = mxv;
            __syncthreads();
            if (it + G < NEX * 8) B2_LOAD(it + G);
            if (tid < 64) { float mx2 = 0.f;
#pragma unroll
                for (int i8 = 0; i8 < 8; ++i8) mx2 = fmaxf(mx2, pm2[tid + 64 * i8]);
                mx2 = wave_max_f(mx2);
                const float sc = mx2 > 0.f ? mx2 * (1.0f / 127.0f) : 1.0f; if (tid == 0) { inv2[0] = 1.0f / sc; ((float*)(ws + WS_SWD))[it] = sc; } }
            __syncthreads();
            const float iv = inv2[0];
#pragma unroll
            for (int c3 = 0; c3 < 2; ++c3) { const int kc = ks2 + 4 * c3; const LAS float* s = blk + (32 * kc) * 128 + n2;
                unsigned q[8];
#pragma unroll
                for (int w4 = 0; w4 < 8; ++w4) { unsigned pk = 0u;
#pragma unroll
                    for (int b = 0; b < 4; ++b) { int qi = (int)rintf(s[(4 * w4 + b) * 128] * iv); qi = qi > 127 ? 127 : (qi < -127 ? -127 : qi); pk |= ((unsigned)qi & 0xffu) << (8 * b); }
                    q[w4] = pk; }
                unsigned char* dp = ws + WS_WD + (size_t)drow * 256 + 32 * kc;
                *(GAS v4u*)dp = (v4u){q[0], q[1], q[2], q[3]}; *(GAS v4u*)(dp + 16) = (v4u){q[4], q[5], q[6], q[7]}; }
            __syncthreads();
        }
#undef B2_LOAD
    }
    LAS float* scr = (LAS float*)(lds + wave * 16384);
    const int gw = blockIdx.x * NWAVES + wave, NGW = G * NWAVES;
    constexpr int I_IN = 16 * 56, I_OUT = 16 * 32, I_R = 16 * 8, I_SD = 4 * 32, I_E = 128;
    constexpr int NSMALL = I_OUT + I_R;
    constexpr int NITEMS = NSMALL;
    for (int it = gw; it < NITEMS; it += NGW) {
        int r = it;
        if (r < NSMALL) {
            if (r < I_OUT) { const int kb = r / 32, nb = r % 32; transpose_tile(inp(12) + (size_t)(64 * kb) * 1024 + 32 * nb, 1024, (bf16*)(ws + WS_WOUT) + (size_t)(32 * nb) * 1024 + 64 * kb, 1024, scr, lane); continue; } r -= I_OUT;
            if (r < I_R) { const int kb = r / 8, nb = r % 8; transpose_tile(inp(13) + (size_t)(64 * kb) * 256 + 32 * nb, 256, (bf16*)(ws + WS_WRS) + (size_t)(32 * nb) * 1024 + 64 * kb, 1024, scr, lane); continue; } r -= I_R;
        }
    }
}

__device__ __forceinline__ void norm_phase(const float* src, bf16* dst, const float* mod, int shoff, int lane, int wave, int G) {
    const int gw = blockIdx.x * NWAVES + wave, NGW = G * NWAVES;
    for (int m = gw; m < T; m += NGW) {
        const GAS f32x4* xr = (const GAS f32x4*)(src + (size_t)m * D) + lane;
        const float* mb = mod + (size_t)(m >> 12) * 6144 + shoff;
        f32x4 v[4]; float s = 0.f;
#pragma unroll
        for (int j = 0; j < 4; ++j) { v[j] = xr[64 * j]; s += (v[j].x * v[j].x + v[j].y * v[j].y) + (v[j].z * v[j].z + v[j].w * v[j].w); }
        const float r = 1.0f / sqrtf(wave_sum(s) * (1.f / D) + EPS);
        GAS v2u* o8 = (GAS v2u*)(dst + (size_t)m * D) + lane;
#pragma unroll
        for (int j = 0; j < 4; ++j) { const f32x4 sh = *(const f32x4*)(mb + 4 * lane + 256 * j), sc = *(const f32x4*)(mb + 1024 + 4 * lane + 256 * j);
            const f32x4 y = v[j] * r * (sc + 1.0f) + sh; v2u o; o.x = pkbf(y.x, y.y); o.y = pkbf(y.z, y.w); o8[64 * j] = o; }
    }
}

__device__ __forceinline__ void quant_phase(const bf16* src, unsigned char* dst, float* scales, int lane, int wave, int G) {
    const int gw = blockIdx.x * NWAVES + wave, NGW = G * NWAVES;
    for (int t = gw; t < T; t += NGW) {
        const GAS v4u* sp = (const GAS v4u*)(src + (size_t)t * D + 16 * lane);
        const v4u a0 = sp[0], a1 = sp[1];
        float v[16];
        v[0] = bflo(a0.x); v[1] = bfhi(a0.x); v[2] = bflo(a0.y); v[3] = bfhi(a0.y); v[4] = bflo(a0.z); v[5] = bfhi(a0.z); v[6] = bflo(a0.w); v[7] = bfhi(a0.w);
        v[8] = bflo(a1.x); v[9] = bfhi(a1.x); v[10] = bflo(a1.y); v[11] = bfhi(a1.y); v[12] = bflo(a1.z); v[13] = bfhi(a1.z); v[14] = bflo(a1.w); v[15] = bfhi(a1.w);
        float mxv = 0.f;
#pragma unroll
        for (int i = 0; i < 16; ++i) mxv = fmaxf(mxv, fabsf(v[i]));
        mxv = wave_max_f(mxv);
        const float sc = mxv > 0.f ? mxv * (1.0f / 127.0f) : 1.0f, iv = 1.0f / sc;
        unsigned q[4];
#pragma unroll
        for (int w4 = 0; w4 < 4; ++w4) { unsigned pk = 0u;
#pragma unroll
            for (int b = 0; b < 4; ++b) { int qi = (int)rintf(v[4 * w4 + b] * iv); qi = qi > 127 ? 127 : (qi < -127 ? -127 : qi); pk |= ((unsigned)qi & 0xffu) << (8 * b); }
            q[w4] = pk; }
        *(GAS v4u*)(dst + (size_t)t * D + 16 * lane) = (v4u){q[0], q[1], q[2], q[3]};
        if (lane == 0) scales[t] = sc;
    }
}

__device__ __forceinline__ void norm_quant_phase(const float* src, unsigned char* dst, float* scales, const float* mod, int lane, int wave, int G) {
    const int gw = blockIdx.x * NWAVES + wave, NGW = G * NWAVES;
    for (int m = gw; m < T; m += NGW) {
        const GAS f32x4* xr = (const GAS f32x4*)(src + (size_t)m * D + 16 * lane);
        const float* mb = mod + (size_t)(m >> 12) * 6144 + 16 * lane;
        f32x4 v[4]; float s = 0.f;
#pragma unroll
        for (int j = 0; j < 4; ++j) { v[j] = xr[j]; s += (v[j].x * v[j].x + v[j].y * v[j].y) + (v[j].z * v[j].z + v[j].w * v[j].w); }
        const float r = 1.0f / sqrtf(wave_sum_dpp(s) * (1.f / D) + EPS);
        float mxv = 0.f;
#pragma unroll
        for (int j = 0; j < 4; ++j) { const f32x4 sh = *(const f32x4*)(mb + 4 * j), sc = *(const f32x4*)(mb + 1024 + 4 * j);
            v[j] = v[j] * r * (sc + 1.0f) + sh; mxv = fmaxf(mxv, fmaxf(fmaxf(fabsf(v[j].x), fabsf(v[j].y)), fmaxf(fabsf(v[j].z), fabsf(v[j].w)))); }
        mxv = wave_max_f(mxv);
        const float qs = mxv > 0.f ? mxv * (1.0f / 127.0f) : 1.0f, iv = 1.0f / qs;
        unsigned q[4];
#pragma unroll
        for (int j = 0; j < 4; ++j) { unsigned pk = 0u;
#pragma unroll
            for (int b = 0; b < 4; ++b) { int qi = (int)rintf(v[j][b] * iv); qi = qi > 127 ? 127 : (qi < -127 ? -127 : qi); pk |= ((unsigned)qi & 0xffu) << (8 * b); }
            q[j] = pk; }
        *(GAS v4u*)(dst + (size_t)m * D + 16 * lane) = (v4u){q[0], q[1], q[2], q[3]};
        if (lane == 0) scales[m] = qs;
    }
}
__device__ __forceinline__ void quant_rows(const bf16* src, unsigned char* dst, float* scales, LAS float* rs, int row0, int lane, int wave) {
    for (int r = wave; r < 256; r += NWAVES) { const int t = row0 + r;
        const GAS v4u* sp = (const GAS v4u*)(src + (size_t)t * D + 16 * lane);
        const v4u a0 = sp[0], a1 = sp[1];
        float v[16];
        v[0] = bflo(a0.x); v[1] = bfhi(a0.x); v[2] = bflo(a0.y); v[3] = bfhi(a0.y); v[4] = bflo(a0.z); v[5] = bfhi(a0.z); v[6] = bflo(a0.w); v[7] = bfhi(a0.w);
        v[8] = bflo(a1.x); v[9] = bfhi(a1.x); v[10] = bflo(a1.y); v[11] = bfhi(a1.y); v[12] = bflo(a1.z); v[13] = bfhi(a1.z); v[14] = bflo(a1.w); v[15] = bfhi(a1.w);
        float mxv = 0.f;
#pragma unroll
        for (int i = 0; i < 16; ++i) mxv = fmaxf(mxv, fabsf(v[i]));
        mxv = wave_max_f(mxv);
        const float sc = mxv > 0.f ? mxv * (1.0f / 127.0f) : 1.0f, iv = 1.0f / sc;
        unsigned q[4];
#pragma unroll
        for (int w4 = 0; w4 < 4; ++w4) { unsigned pk = 0u;
#pragma unroll
            for (int b = 0; b < 4; ++b) { int qi = (int)rintf(v[4 * w4 + b] * iv); qi = qi > 127 ? 127 : (qi < -127 ? -127 : qi); pk |= ((unsigned)qi & 0xffu) << (8 * b); }
            q[w4] = pk; }
        *(GAS v4u*)(dst + (size_t)t * D + 16 * lane) = (v4u){q[0], q[1], q[2], q[3]};
        if (lane == 0) { scales[t] = sc; rs[r] = sc; }
    }
}

constexpr int VT_LD = 260;
constexpr int BD_LD = 192;
constexpr int AL_VT = 0, AL_BIAS = 2 * 64 * VT_LD * 2  , AL_SS = AL_BIAS + 8 * BD_LD * 4, AL_GAIN = AL_SS + 2 * 8 * 32 * 4, AL_END = AL_GAIN + 512 * 4;
constexpr int CL_U = 0, CL_C = 31 * 512 * 4  ;
static_assert(AL_END <= RING_BYTES && 2 * CL_C + 4096 <= RING_BYTES, "P3 LDS");
#define MFMA32(a, b, c) __builtin_amdgcn_mfma_f32_32x32x16_bf16((a), (b), (c), 0, 0, 0)
#define LDS_BAR() do { asm volatile("s_waitcnt lgkmcnt(0)" ::: "memory"); __builtin_amdgcn_s_barrier(); asm volatile("" ::: "memory"); } while (0)
__device__ __forceinline__ void p3_unit(const Args& a, LAS unsigned char* lds, int unit, int tid, int lane, int wave) {
    unsigned char* ws = a.ws;
    const bf16* proj = (const bf16*)(ws + WS_PROJ);
    bf16* cat = (bf16*)(ws + WS_CAT);
    const int b = unit >> 5, qb = unit & 31, t0 = b * SEQ + qb * 128;
#ifndef REP_ATT
#define REP_ATT 1
#endif
#ifndef REP_CONV
#define REP_CONV 1
#endif
#pragma nounroll
    for (int ra_ = 0; ra_ < REP_ATT; ++ra_)
    {
        LAS bf16* vt = (LAS bf16*)(lds + AL_VT);
        LAS float* biasd = (LAS float*)(lds + AL_BIAS);
        LAS float* ssb = (LAS float*)(lds + AL_SS);
#pragma unroll
        for (int i = 0; i < 4; ++i) { const int p = tid + NTHR * i, kp = p & 127, c16 = p >> 7, ki = 2 * kp; const int tk = (qb == 0 && ki < 128) ? t0 + ki : t0 - 128 + ki;
            const v4u v0 = *(const GAS v4u*)(proj + (size_t)tk * INC + 640 + 8 * c16), v1 = *(const GAS v4u*)(proj + (size_t)(tk + 1) * INC + 640 + 8 * c16);
            LAS unsigned* d = (LAS unsigned*)(vt + (size_t)(8 * c16) * VT_LD + ki);
            d[0 * (VT_LD / 2)] = (v0.x & 0xffffu) | (v1.x << 16); d[1 * (VT_LD / 2)] = (v0.x >> 16) | (v1.x & 0xffff0000u);
            d[2 * (VT_LD / 2)] = (v0.y & 0xffffu) | (v1.y << 16); d[3 * (VT_LD / 2)] = (v0.y >> 16) | (v1.y & 0xffff0000u);
            d[4 * (VT_LD / 2)] = (v0.z & 0xffffu) | (v1.z << 16); d[5 * (VT_LD / 2)] = (v0.z >> 16) | (v1.z & 0xffff0000u);
            d[6 * (VT_LD / 2)] = (v0.w & 0xffffu) | (v1.w << 16); d[7 * (VT_LD / 2)] = (v0.w >> 16) | (v1.w & 0xffff0000u); }
        for (int i = tid; i < 8 * BD_LD; i += NTHR) { const int hh = i / BD_LD, n = i % BD_LD - 32; float bv = 0.f;
            if (n >= 0 && n < 128) { int bk = n; if (n >= 16) { bk = 16 + (int)(log2f((float)n * (1.0f / 16.0f)) * (16.0f / 3.0f)); bk = bk > 31 ? 31 : bk; }
                bv = inp(6)[bk * 8 + hh] * 1.44269504f; }
            biasd[i] = bv; }
        LAS float* gain = (LAS float*)(lds + AL_GAIN);
        gain[tid] = inp(7)[tid];
        __syncthreads();
        const int h = wave, kvh = h >> 2, hh = lane >> 5;
        const float sink2 = inp(5)[h] * 1.44269504f;
        for (int i = 0; i < 4; ++i) {
            int r = lane & 31; asm volatile("" : "+v"(r));
            const int tq = t0 + 32 * i + r;
            bf16x8 qf[4];
#pragma unroll
            for (int s = 0; s < 4; ++s) qf[s] = *(const GAS bf16x8*)(proj + (size_t)tq * INC + h * 64 + 16 * s + 8 * hh);
            f32x16 sc[5];
#pragma unroll
            for (int kb = 0; kb < 5; ++kb) {
                const int ki = 32 * (i + kb) + r; const int tk = (qb == 0 && ki < 128) ? t0 + (ki & 127) : t0 - 128 + ki;
                bf16x8 kf[4];
#pragma unroll
                for (int s = 0; s < 4; ++s) kf[s] = *(const GAS bf16x8*)(proj + (size_t)tk * INC + 512 + kvh * 64 + 16 * s + 8 * hh);
                f32x16 acc;
#pragma unroll
                for (int e = 0; e < 16; ++e) acc[e] = 0.f;
#pragma unroll
                for (int s = 0; s < 4; ++s) acc = MFMA32(kf[s], qf[s], acc);
                sc[kb] = acc;
            }
            const LAS float* bdr = biasd + h * BD_LD + 32 + 128 + r - 4 * hh;
            float mx = sink2;
#pragma unroll
            for (int kb = 0; kb < 5; ++kb) {
                const bool tile_ok = qb > 0 || (i + kb) >= 4;
#pragma unroll
                for (int e = 0; e < 16; ++e) { const int kk0 = (e & 3) + 8 * (e >> 2); const int kk = kk0 + 4 * hh;
                    bool ok = tile_ok; if (kb == 0) ok = ok && (kk > r); if (kb == 4) ok = ok && (kk <= r);
                    const float bv = bdr[-32 * kb - kk0];
                    const float lv = sc[kb][e] * (0.125f * 1.44269504f) + bv; const float lg = ok ? lv : -INFINITY; sc[kb][e] = lg; mx = fmaxf(mx, lg); } }
            mx = fmaxf(mx, __shfl_xor(mx, 32));
            float sum = 0.f;
#pragma unroll
            for (int kb = 0; kb < 5; ++kb)
#pragma unroll
                for (int e = 0; e < 16; ++e) { const float p = __builtin_amdgcn_exp2f(sc[kb][e] - mx); sc[kb][e] = p; sum += p; }
            sum += __shfl_xor(sum, 32);
            const float inv = 1.0f / (sum + __builtin_amdgcn_exp2f(sink2 - mx));
            f32x16 o0, o1;
#pragma unroll
            for (int e = 0; e < 16; ++e) { o0[e] = 0.f; o1[e] = 0.f; }
#pragma unroll
            for (int kb = 0; kb < 5; ++kb)
#pragma unroll
                for (int s = 0; s < 2; ++s) {
                    v4u pw; pw.x = pkbf(sc[kb][8 * s + 0], sc[kb][8 * s + 1]); pw.y = pkbf(sc[kb][8 * s + 2], sc[kb][8 * s + 3]); pw.z = pkbf(sc[kb][8 * s + 4], sc[kb][8 * s + 5]); pw.w = pkbf(sc[kb][8 * s + 6], sc[kb][8 * s + 7]);
                    const bf16x8 pf = __builtin_bit_cast(bf16x8, pw);
                    const int kcol = 32 * (i + kb) + 16 * s + 4 * hh;
                    const LAS bf16* v0 = vt + (size_t)(kvh * 64 + r) * VT_LD + kcol;
                    const s16x4 a0 = *(const LAS s16x4*)v0, a1 = *(const LAS s16x4*)(v0 + 8);
                    const s16x4 c0 = *(const LAS s16x4*)(v0 + 32 * VT_LD), c1 = *(const LAS s16x4*)(v0 + 32 * VT_LD + 8);
                    o0 = MFMA32(__builtin_shufflevector(a0, a1, 0, 1, 2, 3, 4, 5, 6, 7), pf, o0);
                    o1 = MFMA32(__builtin_shufflevector(c0, c1, 0, 1, 2, 3, 4, 5, 6, 7), pf, o1);
                }
            float ss = 0.f;
#pragma unroll
            for (int e = 0; e < 16; ++e) { o0[e] *= inv; o1[e] *= inv; ss += o0[e] * o0[e] + o1[e] * o1[e]; }
            ss += __shfl_xor(ss, 32);
            LAS float* sb = ssb + (i & 1) * 256;
            if (hh == 0) sb[h * 32 + r] = ss;
            LDS_BAR();
            float tot = 0.f;
#pragma unroll
            for (int w = 0; w < 8; ++w) tot += sb[w * 32 + r];
            const float rn = 1.0f / sqrtf(tot * (1.0f / 512.0f) + EPS);
            bf16* orow = cat + (size_t)tq * D + h * 64 + 4 * hh;
            const LAS float* gp = gain + h * 64 + 4 * hh;
#pragma unroll
            for (int g = 0; g < 4; ++g) {
                const f32x4 g0 = *(const LAS f32x4*)(gp + 8 * g), g1 = *(const LAS f32x4*)(gp + 32 + 8 * g);
                v2u w0, w1;
                w0.x = pkbf(o0[4 * g + 0] * rn * g0.x, o0[4 * g + 1] * rn * g0.y); w0.y = pkbf(o0[4 * g + 2] * rn * g0.z, o0[4 * g + 3] * rn * g0.w);
                w1.x = pkbf(o1[4 * g + 0] * rn * g1.x, o1[4 * g + 1] * rn * g1.y); w1.y = pkbf(o1[4 * g + 2] * rn * g1.z, o1[4 * g + 3] * rn * g1.w);
                *(GAS v2u*)(orow + 8 * g) = w0; *(GAS v2u*)(orow + 32 + 8 * g) = w1;
            }
        }
        __syncthreads();
    }
#pragma nounroll
    for (int rc_ = 0; rc_ < REP_CONV; ++rc_)
    {
        LAS float* ub = (LAS float*)(lds + CL_U);
        LAS float* cb = (LAS float*)(lds + CL_C);
        __builtin_amdgcn_sched_barrier(0);
        int c = tid, ln8 = 8 * lane; asm volatile("" : "+v"(c), "+v"(ln8));
        float w[CW], acc[CW];
#pragma unroll
        for (int j = 0; j < CW; ++j) { w[j] = inp(8)[j * CC + c]; acc[j] = 0.f; }
        const float cbias = inp(9)[c];
        LAS float* lnp = (LAS float*)(lds + 2 * CL_C);
        lnp[c] = inp(10)[c]; lnp[512 + c] = inp(11)[c];
        v4u av[4], gv[4];
#define CONV_LOAD(grp_) do { const int tb_ = -30 + 31 * (grp_); _Pragma("unroll") for (int i4 = 0; i4 < 4; ++i4) { const int it = c + NTHR * i4, s = it >> 6, ch = (it & 63) * 8, tr = tb_ + s; \
            const bool okl = (it < 31 * 64) && tr < 128 && (qb > 0 || tr >= 0); const bf16* pr = proj + (size_t)(t0 + (okl ? tr : 0)) * INC; \
            av[i4] = *(const GAS v4u*)(pr + 768 + ch); gv[i4] = okl ? *(const GAS v4u*)(pr + 1280 + ch) : (v4u){0xff80ff80u, 0xff80ff80u, 0xff80ff80u, 0xff80ff80u}; } } while (0)
        CONV_LOAD(0);
        for (int grp = 0; grp < 6; ++grp) {
            const int tb = -30 + 31 * grp;
#pragma unroll
            for (int i4 = 0; i4 < 4; ++i4) { const int it = c + NTHR * i4, s = it >> 6, ch = (it & 63) * 8;
                if (it < 31 * 64) {
                    f32x4 u0, u1; const v4u a4 = av[i4], g4 = gv[i4];
                    u0.x = bflo(a4.x) * __builtin_amdgcn_rcpf(1.f + __expf(-bflo(g4.x))); u0.y = bfhi(a4.x) * __builtin_amdgcn_rcpf(1.f + __expf(-bfhi(g4.x)));
                    u0.z = bflo(a4.y) * __builtin_amdgcn_rcpf(1.f + __expf(-bflo(g4.y))); u0.w = bfhi(a4.y) * __builtin_amdgcn_rcpf(1.f + __expf(-bfhi(g4.y)));
                    u1.x = bflo(a4.z) * __builtin_amdgcn_rcpf(1.f + __expf(-bflo(g4.z))); u1.y = bfhi(a4.z) * __builtin_amdgcn_rcpf(1.f + __expf(-bfhi(g4.z)));
                    u1.z = bflo(a4.w) * __builtin_amdgcn_rcpf(1.f + __expf(-bflo(g4.w))); u1.w = bfhi(a4.w) * __builtin_amdgcn_rcpf(1.f + __expf(-bfhi(g4.w)));
                    *(LAS f32x4*)(ub + s * 512 + ch) = u0; *(LAS f32x4*)(ub + s * 512 + ch + 4) = u1; } }
            if (grp < 5) CONV_LOAD(grp + 1);
            LDS_BAR();
#pragma unroll
            for (int s = 0; s < CW; ++s) {
                const float u = ub[s * 512 + c];
#pragma unroll
                for (int j = 0; j < CW; ++j) acc[(s + 30 - j) % CW] += w[j] * u;
                cb[s * 512 + c] = acc[s] + cbias; acc[s] = 0.f;
            }
            LDS_BAR();
#pragma nounroll
            for (int itn = 0; itn < 2; ++itn) { const int s = 2 * wave + (lane >> 5) + 16 * itn; const int tr = tb + s; const bool okt = s < CW && tr >= 0 && tr < 128;
                const LAS float* cp = cb + (okt ? s : 0) * 512 + 16 * (lane & 31);
                f32x4 xq[4]; float sm = 0.f;
#pragma unroll
                for (int q4 = 0; q4 < 4; ++q4) { xq[q4] = *(const LAS f32x4*)(cp + 4 * q4); sm += (xq[q4].x + xq[q4].y) + (xq[q4].z + xq[q4].w); }
                sm = dpp16_sum(sm); sm += __shfl_xor(sm, 16);
                const float mu = sm * (1.f / 512.f); float sq = 0.f;
#pragma unroll
                for (int q4 = 0; q4 < 4; ++q4) { xq[q4] = xq[q4] - mu; sq += (xq[q4].x * xq[q4].x + xq[q4].y * xq[q4].y) + (xq[q4].z * xq[q4].z + xq[q4].w * xq[q4].w); }
                sq = dpp16_sum(sq); sq += __shfl_xor(sq, 16);
                const float rs = 1.0f / sqrtf(sq * (1.f / 512.f) + EPS);
                v4u o0, o1;
                { const LAS float* gq = lnp + 16 * (lane & 31); const f32x4 y0 = xq[0] * rs * *(const LAS f32x4*)gq + *(const LAS f32x4*)(gq + 512), y1 = xq[1] * rs * *(const LAS f32x4*)(gq + 4) + *(const LAS f32x4*)(gq + 516); o0.x = pkbf(silu_f(y0.x), silu_f(y0.y)); o0.y = pkbf(silu_f(y0.z), silu_f(y0.w)); o0.z = pkbf(silu_f(y1.x), silu_f(y1.y)); o0.w = pkbf(silu_f(y1.z), silu_f(y1.w)); }
                { const LAS float* gq = lnp + 16 * (lane & 31) + 8; const f32x4 y0 = xq[2] * rs * *(const LAS f32x4*)gq + *(const LAS f32x4*)(gq + 512), y1 = xq[3] * rs * *(const LAS f32x4*)(gq + 4) + *(const LAS f32x4*)(gq + 516); o1.x = pkbf(silu_f(y0.x), silu_f(y0.y)); o1.y = pkbf(silu_f(y0.z), silu_f(y0.w)); o1.z = pkbf(silu_f(y1.x), silu_f(y1.y)); o1.w = pkbf(silu_f(y1.z), silu_f(y1.w)); }
                if (okt) { GAS v4u* op = (GAS v4u*)(cat + (size_t)(t0 + tr) * D + 512 + 16 * (lane & 31)); op[0] = o0; op[1] = o1; }
            }
        }
#undef CONV_LOAD
        __syncthreads();
    }
}

constexpr int CSTRIDE = 64;
__device__ __forceinline__ float dpp8_max(float x) {
    int v = (int)__float_as_uint(x);
#define D8_STEP(ctrl) { const int o = __builtin_amdgcn_update_dpp(v, v, ctrl, 0xf, 0xf, false); v = (int)__float_as_uint(fmaxf(__uint_as_float((unsigned)v), __uint_as_float((unsigned)o))); }
    D8_STEP(0xb1) D8_STEP(0x4e) D8_STEP(0x141)
#undef D8_STEP
    return __uint_as_float((unsigned)v);
}
__device__ __forceinline__ float dpp16_max(float x) {
    int v = (int)__float_as_uint(x);
#define D8_STEP(ctrl) { const int o = __builtin_amdgcn_update_dpp(v, v, ctrl, 0xf, 0xf, false); v = (int)__float_as_uint(fmaxf(__uint_as_float((unsigned)v), __uint_as_float((unsigned)o))); }
    D8_STEP(0xb1) D8_STEP(0x4e) D8_STEP(0x141) D8_STEP(0x140)
#undef D8_STEP
    return __uint_as_float((unsigned)v);
}
__device__ __forceinline__ float dpp8_sum(float x) {
    int v = (int)__float_as_uint(x);
#define D8_STEP(ctrl) { const int o = __builtin_amdgcn_update_dpp(v, v, ctrl, 0xf, 0xf, false); v = (int)__float_as_uint(__uint_as_float((unsigned)v) + __uint_as_float((unsigned)o)); }
    D8_STEP(0xb1) D8_STEP(0x4e) D8_STEP(0x141)
#undef D8_STEP
    return __uint_as_float((unsigned)v);
}
__device__ __forceinline__ void p7_phase(const Args& a, LAS unsigned char* lds, int tid, int lane, int wave, int G) {
    unsigned char* ws = a.ws;
    const float* logits = (const float*)(ws + WS_LOGITS);
    int* counts = (int*)(ws + WS_CTL) + CW_COUNTS;
    LAS int* hist = (LAS int*)lds;
    LAS int* cbase = (LAS int*)(lds + 1024);
    LAS float* rbias = (LAS float*)(lds + 2048);
    int* eidx_g = (int*)(ws + WS_EIDX); float* gw_g = (float*)(ws + WS_GW); int* pos_g = (int*)(ws + WS_POS);
    const int g = lane & 7, gb = lane & ~7;
    for (int ch = blockIdx.x; ch < T / 128; ch += G) {
        if (tid < NE) { hist[tid] = 0; rbias[tid] = inp(14)[tid]; }
        __syncthreads();
#pragma nounroll
        for (int ps = 0; ps < 2; ++ps) {
            const int t = ch * 128 + ps * 64 + (tid >> 3);
            float sel[32];
            const GAS f32x4* lp = (const GAS f32x4*)(logits + (size_t)t * NE + 32 * g);
#pragma unroll
            for (int i = 0; i < 8; ++i) { const f32x4 lg = lp[i]; const f32x4 rb = *(const LAS f32x4*)(rbias + 32 * g + 4 * i);
#pragma unroll
                for (int e = 0; e < 4; ++e) sel[4 * i + e] = 1.0f / (1.0f + __expf(-lg[e])) + rb[e]; }
            float m1 = -INFINITY, m2 = -INFINITY;
#pragma unroll
            for (int i = 0; i < 32; ++i) { const float v = sel[i]; m2 = fmaxf(m2, fminf(m1, v)); m1 = fmaxf(m1, v); }
            const float gs = m1 + m2; int rank = 0;
#pragma unroll
            for (int j = 0; j < 8; ++j) { const float o = __shfl(gs, gb + j); rank += (o > gs || (o == gs && j < g)) ? 1 : 0; }
            const bool selected = rank < 4;
            float lv[8]; int li[8];
#pragma unroll
            for (int k = 0; k < 8; ++k) { lv[k] = -INFINITY; li[k] = 0; }
            if (selected) {
#pragma unroll
                for (int i = 0; i < 32; ++i) { float v = sel[i]; int id = 32 * g + i;
#pragma unroll
                    for (int k = 0; k < 8; ++k) { const bool sw = v > lv[k]; const float tv = sw ? lv[k] : v; const int ti = sw ? li[k] : id; lv[k] = sw ? v : lv[k]; li[k] = sw ? id : li[k]; v = tv; id = ti; } }
            }
            float mysel = 0.f; int mye = 0;
#pragma unroll
            for (int rd = 0; rd < TOPK; ++rd) {
                const float mx = dpp8_max(lv[0]);
                const unsigned long long bal = __ballot(lv[0] == mx);
                const int wl = __builtin_ctz((unsigned)((bal >> gb) & 0xffull));
                const int widx = __shfl(li[0], gb + wl);
                if (g == wl) {
#pragma unroll
                    for (int k = 0; k < 7; ++k) { lv[k] = lv[k + 1]; li[k] = li[k + 1]; }
                    lv[7] = -INFINITY; }
                if (g == rd) { mysel = mx; mye = widx; }
            }
            const float mysc = mysel - rbias[mye];
            const float tot = dpp8_sum(mysc);
            const int rk = __hip_atomic_fetch_add(hist + mye, 1, __ATOMIC_RELAXED, __HIP_MEMORY_SCOPE_WORKGROUP);
            eidx_g[t * 8 + g] = mye; gw_g[t * 8 + g] = mysc / tot * 2.5f; pos_g[t * 8 + g] = rk;
        }
        __syncthreads();
        if (tid < NE) { const int c = hist[tid]; cbase[tid] = c > 0 ? atomicAdd(counts + CSTRIDE * tid, c) : 0; }
        __syncthreads();
        for (int i = tid; i < 1024; i += NTHR) { const int idx = ch * 1024 + i; const int e = __builtin_nontemporal_load(eidx_g + idx); const int p = __builtin_nontemporal_load(pos_g + idx) + cbase[e];
            pos_g[idx] = p; ((unsigned short*)(ws + WS_LIST))[(size_t)e * T + p] = (unsigned short)(idx >> 3); (ws + WS_SLOT)[(size_t)e * T + p] = (unsigned char)(idx & 7); }
        __syncthreads();
    }
}
__device__ __forceinline__ int build_tiles(const Args& a, LAS unsigned char* lds, int tid) {
    const int* counts = (const int*)(a.ws + WS_CTL) + CW_COUNTS;
    LAS int* base = (LAS int*)(lds + LX_BASE);
    LAS int* pb = (LAS int*)(lds + LX_GL);
    LAS unsigned short* texp = (LAS unsigned short*)(lds + LX_TEXP);
    if (tid < 64) {
        int c[4], p[4], pre = 0, ppre = 0;
#pragma unroll
        for (int i = 0; i < 4; ++i) { const int raw = __hip_atomic_load(counts + CSTRIDE * (4 * tid + i), RLX_AGENT); ((LAS int*)(lds + LX_CNT))[4 * tid + i] = raw; c[i] = (raw + 255) & ~255; pre += c[i];
            const int nt = c[i] >> 8, ch = (nt > 0 && raw - ((nt - 1) << 8) <= 128) ? 1 : 0; p[i] = ((nt - ch) << 16) | ch; ppre += p[i]; }
        int incl = pre, pincl = ppre;
#pragma unroll
        for (int o = 1; o < 64; o <<= 1) { const int x = __shfl_up(incl, o), y = __shfl_up(pincl, o); if (tid >= o) { incl += x; pincl += y; } }
        int run = incl - pre, prun = pincl - ppre;
#pragma unroll
        for (int i = 0; i < 4; ++i) { base[4 * tid + i] = run; run += c[i]; pb[4 * tid + i] = prun; prun += p[i]; }
        if (tid == 63) { base[NE] = run; base[NE + 1] = run + T; ((LAS int*)(lds + LX_CNT))[NE] = T; pb[NE] = prun; pb[NE + 1] = prun + ((T / 256) << 16); }
    }
    __syncthreads();
    if (tid < NEX) { const int t0 = base[tid] >> 8, t1 = base[tid + 1] >> 8; int fi = pb[tid] >> 16; const int ci = pb[tid] & 0xffff, ch = (pb[tid + 1] & 0xffff) - ci;
        for (int t = t0; t < t1; ++t) { texp[t] = (unsigned short)tid; if (ch && t == t1 - 1) ((LAS unsigned short*)(lds + LX_CT))[ci] = (unsigned short)t; else ((LAS unsigned short*)(lds + LX_FT))[fi++] = (unsigned short)t; } }
    __syncthreads();
    return pb[NEX];
}
__device__ __forceinline__ void p11_phase(const Args& a, LAS unsigned char* lds, int tid, int lane, int wave, int G) {
    unsigned char* ws = a.ws;
    const float* mod = (const float*)(ws + WS_MOD);
    const unsigned char* y = ws + WS_Y;
    const float* gwv = (const float*)(ws + WS_GW);
    const float* xin = a.out; float* out = a.aux ? (float*)(ws + WS_HID) : a.out;
    const float* fg = inp(21);
    typedef float f32x2 __attribute__((ext_vector_type(2)));
    const int gw = blockIdx.x * NWAVES + wave, NGW = G * NWAVES;
    for (int t = gw; t < T; t += NGW) {
        const float* g2 = mod + (size_t)(t >> 12) * 6144 + 5120 + 16 * lane;
        float myw = 0.f;
        if (lane < TOPK) myw = gwv[t * 8 + lane];
        const GAS v4u* yr = (const GAS v4u*)(y + (size_t)t * NSLOT * D + 16 * lane);
        v4u yv[NSLOT];
#pragma unroll
        for (int k = 0; k < NSLOT; ++k) yv[k] = yr[k * (D / 16)];
        f32x4 xv[4];
        { const GAS v4u* xp = (const GAS v4u*)((const bf16*)xin + (size_t)t * (2 * D) + 16 * lane); const v4u x0 = xp[0], x1v = xp[1];
            xv[0] = (f32x4){bflo(x0.x), bfhi(x0.x), bflo(x0.y), bfhi(x0.y)}; xv[1] = (f32x4){bflo(x0.z), bfhi(x0.z), bflo(x0.w), bfhi(x0.w)};
            xv[2] = (f32x4){bflo(x1v.x), bfhi(x1v.x), bflo(x1v.y), bfhi(x1v.y)}; xv[3] = (f32x4){bflo(x1v.z), bfhi(x1v.z), bflo(x1v.w), bfhi(x1v.w)}; }
        f32x4 m4[4];
#pragma unroll
        for (int j = 0; j < 4; ++j) m4[j] = (f32x4){0.f, 0.f, 0.f, 0.f};
#pragma unroll
        for (int k = 0; k < NSLOT; ++k) {
            const float wk = k < TOPK ? __uint_as_float((unsigned)__builtin_amdgcn_readlane((int)__float_as_uint(myw), k < TOPK ? k : 0)) : 1.0f;
#pragma unroll
            for (int j = 0; j < 4; ++j) { const f32x2 lo = __builtin_amdgcn_cvt_pk_f32_fp8((int)yv[k][j], false), hi = __builtin_amdgcn_cvt_pk_f32_fp8((int)yv[k][j], true);
                m4[j] += (f32x4){lo.x, lo.y, hi.x, hi.y} * wk; }
        }
        f32x4 v[4]; float s = 0.f;
#pragma unroll
        for (int j = 0; j < 4; ++j) { v[j] = xv[j] + *(const f32x4*)(g2 + 4 * j) * m4[j]; s += (v[j].x * v[j].x + v[j].y * v[j].y) + (v[j].z * v[j].z + v[j].w * v[j].w); }
        const float r = 1.0f / sqrtf(wave_sum_dpp(s) * (1.f / D) + EPS);
#pragma unroll
        for (int j = 0; j < 4; ++j) *(GAS f32x4*)(out + (size_t)t * D + 16 * lane + 4 * j) = v[j] * r * *(const f32x4*)(fg + 16 * lane + 4 * j);
    }
}

__global__ void __launch_bounds__(NTHR, 2) hyb_fwd(Args args) {
    extern __shared__ __attribute__((aligned(16))) unsigned char lds_raw[];
    LAS unsigned char* lds = (LAS unsigned char*)lds_raw;
    volatile LAS unsigned* MISC = (volatile LAS unsigned*)(lds + LX_MISC);
    const int tid = threadIdx.x, lane = tid & 63, wave = __builtin_amdgcn_readfirstlane(tid >> 6), G = gridDim.x;
    unsigned char* ws = args.ws;
    if (tid < 64) MISC[tid] = 0u;
    __syncthreads();
    XcdBarrier bar; bar.bar = (unsigned*)(ws + WS_CTL) + CW_BAR; bar.x = 0; bar.st = nullptr;
    if (!MK_MULTI) bar = xcd_barrier_post((unsigned*)(ws + WS_CTL) + CW_BAR, MISC + 8);
    const int lo = args.ph_lo, hi = args.ph_hi;
#ifndef PH_REPEAT
#define PH_REPEAT 0
#endif
#define IN(k) (lo <= (k) && (k) < hi)
#define SEAM(k) do { if (IN(k) && IN((k) + 1)) xcd_barrier(bar); } while (0)
#define REP(k) for (int rep_ = 0; rep_ < (((PH_REPEAT >> (k)) & 1) ? 2 : 1); ++rep_, (((PH_REPEAT >> (k)) & 1) && rep_ == 1 ? xcd_barrier(bar) : (void)0))
    const float* mod = (const float*)(ws + WS_MOD);
    bf16* Hb = (bf16*)(ws + WS_H);

#ifndef PAD_NOPS
#define PAD_NOPS 0
#endif
    if (PAD_NOPS > 0 && G == 0x7fffffff) { _Pragma("unroll") for (int pn_ = 0; pn_ < PAD_NOPS; ++pn_) asm volatile("s_nop 0"); }
    if (IN(0)) { REP(0) { p0_phase(args, lds, tid, lane, wave, G); } SEAM(0); }
    if (IN(1)) { REP(1) { norm_quant_phase(inp(0), (unsigned char*)Hb, (float*)(ws + WS_SA1), mod, lane, wave, G); } SEAM(1); }
    if (IN(2)) { REP(2) {
        pg8::MoeStream MS{(const unsigned char*)Hb, ws + WS_WINQ, (const float*)(ws + WS_SWIN), (bf16*)(ws + WS_PROJ), nullptr, nullptr, (const float*)(ws + WS_SA1), nullptr, nullptr, nullptr, nullptr, nullptr, nullptr, 0};
        MS.order.init(T, INC, G, (int)blockIdx.x);
        pg8::moe_stream<2>(lds, MS);
        } SEAM(2);
    }
    if (IN(3)) { REP(3) { for (int u = blockIdx.x; u < NB * 32; u += G) p3_unit(args, lds, u, tid, lane, wave); } SEAM(3); }
    if (IN(4)) { REP(4) {
        pg8::Gemm g{(const bf16*)(ws + WS_CAT), (const bf16*)(ws + WS_WOUT), T, D, D};
        bf16* H2 = Hb;
        for (int rnd = 0; rnd * G < (T / 256) * (D / 256); ++rnd) {
            pg8::RoundSched S; S.base.init(T, D, G, (int)blockIdx.x); S.round = rnd;
            pg8::EpiResidNorm E{inp(0), args.out, mod, H2, (float*)(ws + WS_LOGITS), (unsigned*)(ws + WS_CTL) + CW_PANEL + rnd * 128 * 64, EPS};
            pg8::gemm_phase<pg8::EpiResidNorm, pg8::RoundSched, false, true>(lds, g, S, E);
        }
        } SEAM(5);
    }
    if (IN(6)) { REP(6) {
        for (int uu = blockIdx.x; uu < T / 256; uu += G) {
            pg8::Gemm g{Hb, (const bf16*)(ws + WS_WRS), T, 256, D}; pg8::OneUnit S{uu, 0};
            pg8::EpiRouterShared E{(float*)(ws + WS_LOGITS), nullptr};
            pg8::gemm_phase<pg8::EpiRouterShared, pg8::OneUnit, true, true>(lds, g, S, E);
            __syncthreads();
        }
        for (int uu = (int)blockIdx.x < T / 256 ? (int)blockIdx.x + ((T / 256 + G - 1 - (int)blockIdx.x) / G) * G : (int)blockIdx.x; uu < 2 * (T / 256); uu += G)
            quant_rows(Hb, ws + WS_H2Q, (float*)(ws + WS_SA), (LAS float*)(lds + LX_RS), (uu - T / 256) * 256, lane, wave);
        } SEAM(6);
    }
    if (IN(7)) { REP(7) { p7_phase(args, lds, tid, lane, wave, G); } SEAM(7); }
    if (IN(9)) { REP(9) {
        const int fc = build_tiles(args, lds, tid), nfull = fc >> 16, ncheap = fc & 0xffff;
        const LAS unsigned short* texp = (const LAS unsigned short*)(lds + LX_TEXP);
        int xq = 0, wi = blockIdx.x, step = G, sh = 0;
        if ((G & 7) == 0) { xq = blockIdx.x & 7; wi = blockIdx.x >> 3; step = G >> 3; sh = 3; }
        const int f_lo = (int)(((long)xq * nfull) >> sh), f_hi = (int)(((long)(xq + 1) * nfull) >> sh), c_lo = (int)(((long)xq * ncheap) >> sh), c_hi = (int)(((long)(xq + 1) * ncheap) >> sh);
        const int nF = f_hi - f_lo, nC = c_hi - c_lo;
        const int nf = wi < nF ? (nF - wi + step - 1) / step : 0;
        const int j0 = (((wi - nF) % step) + step) % step;
        const int nc = j0 < nC ? (nC - j0 + step - 1) / step : 0;
        const int ntl = nf + nc;
        LAS unsigned short* mt = (LAS unsigned short*)(lds + LX_MY); LAS unsigned short* mr = mt + 16;
        for (int tl0 = 0; tl0 < ntl; tl0 += 6) {
            const int nn = (ntl - tl0) < 6 ? (ntl - tl0) : 6;
            if (tid < nn) { const int idx = tl0 + tid; const int t = idx < nf ? (int)((const LAS unsigned short*)(lds + LX_FT))[f_lo + wi + step * idx] : (int)((const LAS unsigned short*)(lds + LX_CT))[c_lo + j0 + step * (idx - nf)];
                const int ex = (int)texp[t]; int R = ((const LAS int*)(lds + LX_CNT))[ex] - (t * 256 - ((const LAS int*)(lds + LX_BASE))[ex]); R = R > 256 ? 256 : R; mt[tid] = (unsigned short)t; mr[tid] = (unsigned short)R; }
            __syncthreads();
            LAS unsigned short* gl = (LAS unsigned short*)(lds + LX_GL);
            for (int i = tid; i < nn * 256; i += NTHR) { const int sl = i >> 8, r = i & 255, pm = (int)mt[sl]; const int ex = (int)texp[pm], r0 = pm * 256 - ((const LAS int*)(lds + LX_BASE))[ex];
                const bool realr = r < (int)mr[sl];
                const unsigned short tk = !realr ? (unsigned short)0 : (ex == NE ? (unsigned short)(r0 + r) : ((const unsigned short*)(ws + WS_LIST))[(size_t)ex * T + r0 + r]);
                gl[i] = tk; ((LAS float*)(lds + LX_RS))[i] = ((const float*)(ws + WS_SA))[tk];
            }
            for (int i = tid; i < nn * 512; i += NTHR) ((LAS float*)(lds + LX_DST))[i] = ((const float*)(ws + WS_SWGU))[(size_t)texp[mt[i >> 9]] * 512 + (i & 511)];
            if (tid < nn * 8) ((LAS float*)(lds + LX_MY + 64))[tid] = ((const float*)(ws + WS_SWD))[(size_t)texp[mt[tid >> 3]] * 8 + (tid & 7)];
            __syncthreads();
            pg8::MoeStream MS{ws + WS_H2Q, ws + WS_WGU, (const float*)(ws + WS_SWGU), (bf16*)(ws + WS_HID), nullptr, nullptr, nullptr, nullptr, texp, gl, (const LAS float*)(lds + LX_RS), mt, mr, nn}; MS.lsc = (const LAS float*)(lds + LX_DST);
            pg8::moe_stream<0>(lds, MS);
#ifdef PROBE_G1
            __syncthreads(); pg8::moe_stream<0, PROBE_G1>(lds, MS);
#endif
            asm volatile("s_waitcnt vmcnt(0)" ::: "memory"); __syncthreads();
            for (int i = tid; i < nn * 256; i += NTHR) { const int sl = i >> 8, r = i & 255, pm = (int)mt[sl]; const int ex = (int)texp[pm], r0 = pm * 256 - ((const LAS int*)(lds + LX_BASE))[ex];
                ((LAS int*)(lds + LX_DST))[i] = r >= (int)mr[sl] ? -1 : (int)gl[i] * NSLOT + (ex == NE ? TOPK : (int)(ws + WS_SLOT)[(size_t)ex * T + r0 + r]); }
            {
                const bf16* hidp = (const bf16*)(ws + WS_HID); unsigned char* hq = ws + WS_HIDQ; LAS float* rsl = (LAS float*)(lds + LX_RS);
                const int l16 = lane & 15;
                for (int rb = wave * 4 + (lane >> 4); rb < nn * 256; rb += NWAVES * 4 * 4) {
                    v4u a0[4], a1[4]; size_t grow[4];
#pragma unroll
                    for (int u4 = 0; u4 < 4; ++u4) { const int rr = rb + u4 * NWAVES * 4; const int rc = rr < nn * 256 ? rr : rb; const int sl = rc >> 8, r = rc & 255; grow[u4] = (size_t)mt[sl] * 256 + r;
                        const GAS v4u* sp = (const GAS v4u*)(hidp + grow[u4] * 256 + 16 * l16); a0[u4] = sp[0]; a1[u4] = sp[1]; }
#pragma unroll
                    for (int u4 = 0; u4 < 4; ++u4) { const int rr = rb + u4 * NWAVES * 4;
                        float v[16];
                        v[0] = bflo(a0[u4].x); v[1] = bfhi(a0[u4].x); v[2] = bflo(a0[u4].y); v[3] = bfhi(a0[u4].y); v[4] = bflo(a0[u4].z); v[5] = bfhi(a0[u4].z); v[6] = bflo(a0[u4].w); v[7] = bfhi(a0[u4].w);
                        v[8] = bflo(a1[u4].x); v[9] = bfhi(a1[u4].x); v[10] = bflo(a1[u4].y); v[11] = bfhi(a1[u4].y); v[12] = bflo(a1[u4].z); v[13] = bfhi(a1[u4].z); v[14] = bflo(a1[u4].w); v[15] = bfhi(a1[u4].w);
                        float mxv = 0.f;
#pragma unroll
                        for (int i = 0; i < 16; ++i) mxv = fmaxf(mxv, fabsf(v[i]));
                        mxv = dpp16_max(mxv);
                        const float sc = mxv > 0.f ? mxv * (1.0f / 127.0f) : 1.0f, iv = 1.0f / sc;
                        unsigned q[4];
#pragma unroll
                        for (int w4 = 0; w4 < 4; ++w4) { unsigned pk = 0u;
#pragma unroll
                            for (int b = 0; b < 4; ++b) { int qi = (int)rintf(v[4 * w4 + b] * iv); qi = qi > 127 ? 127 : (qi < -127 ? -127 : qi); pk |= ((unsigned)qi & 0xffu) << (8 * b); }
                            q[w4] = pk; }
                        if (rr < nn * 256 && (rr & 255) < (int)mr[rr >> 8]) { *(GAS v4u*)(hq + grow[u4] * 256 + 16 * l16) = (v4u){q[0], q[1], q[2], q[3]};
                            if (l16 == 0) rsl[rr] = sc; } }
                }
                asm volatile("s_waitcnt vmcnt(0)" ::: "memory"); __syncthreads();
            }
            {
                pg8::MoeStream MD{nullptr, nullptr, nullptr, nullptr, ws + WS_HIDQ, ws + WS_WD, (const float*)(ws + WS_SWD), ws + WS_Y, texp, nullptr, (const LAS float*)(lds + LX_RS), mt, mr, nn}; MD.dst = (const LAS int*)(lds + LX_DST); MD.lsc = (const LAS float*)(lds + LX_MY + 64);
                pg8::moe_stream<1>(lds, MD);
#ifdef PROBE_G2
                __syncthreads(); pg8::moe_stream<1, PROBE_G2>(lds, MD);
#endif
            }
            __syncthreads();
        }
        } SEAM(10);
    }
    if (IN(11)) { REP(11) { p11_phase(args, lds, tid, lane, wave, G); } }
#undef IN
#undef SEAM
}

extern "C" void kernel_launch(void* const* d_in, const int* in_sizes, int n_in, void* d_out, int out_size, void* d_ws, size_t ws_size, hipStream_t stream) {
    static int grid = 0;
    if (grid == 0) {
        if (n_in != 22 || in_sizes[0] != T * D || out_size != T * D || ws_size < WS_NEED) { fprintf(stderr, "kernel_launch: unexpected shapes (n_in %d, in0 %d, out %d, ws %zu); nothing launched\n", n_in, n_in > 0 ? in_sizes[0] : -1, out_size, ws_size); grid = -1; return; }
        int dev = 0, cus = 0, per_cu = 0;
        if (hipGetDevice(&dev) != hipSuccess || hipDeviceGetAttribute(&cus, hipDeviceAttributeMultiprocessorCount, dev) != hipSuccess) { grid = -1; return; }
        if (hipFuncSetAttribute((const void*)hyb_fwd, hipFuncAttributeMaxDynamicSharedMemorySize, LDS_BYTES) != hipSuccess) { fprintf(stderr, "kernel_launch: hipFuncSetAttribute failed\n"); grid = -1; return; }
        if (hipOccupancyMaxActiveBlocksPerMultiprocessor(&per_cu, (const void*)hyb_fwd, NTHR, LDS_BYTES) != hipSuccess || per_cu < 1) { fprintf(stderr, "kernel_launch: occupancy query says %d\n", per_cu); }
        (void)hipGetLastError();
        grid = cus;
    }
    if (grid < 0) return;
    if (hipMemsetAsync((char*)d_ws + WS_CTL, 0, CTL_ZERO_BYTES, stream) != hipSuccess) return;
    Args a{};
    for (int i = 0; i < 22; ++i) a.in[i] = (const float*)d_in[i];
    a.out = (float*)d_out; a.ws = (unsigned char*)d_ws;
#if MK_MULTI
#ifndef HOST_REPEAT
#define HOST_REPEAT 0
#endif
    for (int p = 0; p < NPHASE; ++p) for (int r = 0; r < (((HOST_REPEAT >> p) & 1) ? 2 : 1); ++r) { a.ph_lo = p; a.ph_hi = p + 1;
        const bool rep = ((HOST_REPEAT >> p) & 1) != 0;
        a.aux = ((p == 11 || p == 9) && rep && r == 0) ? 1 : 0;
        if (p == 7 && rep && r == 1) (void)hipMemsetAsync((char*)d_ws + WS_CTL + CW_COUNTS * 4, 0, 256 * 64 * 4, stream);
        hipLaunchKernelGGL(hyb_fwd, dim3(grid), dim3(NTHR), LDS_BYTES, stream, a); }
#else
    a.ph_lo = 0; a.ph_hi = NPHASE;
    hipLaunchKernelGGL(hyb_fwd, dim3(grid), dim3(NTHR), LDS_BYTES, stream, a);
#endif
}
```

```cpp
#include <hip/hip_runtime.h>
#include <cstdio>
#include <cstdint>
namespace pg8 {
#define PG8_LAS __attribute__((address_space(3)))
typedef unsigned short bf16_t;
typedef short bf16x8 __attribute__((ext_vector_type(8)));
typedef float f32x4 __attribute__((ext_vector_type(4)));
typedef unsigned u32x4 __attribute__((ext_vector_type(4)));
constexpr int BM = 256, BK = 64, HALF = 128, HTB = HALF * BK * 2  , STAGE_BYTES = 8 * HTB, NXCD = 8, WGM = 8;

__host__ __device__ __forceinline__ int lds_byte(int r, int c) { const int st = (r >> 4) * 2 + (c >> 5), rr = r & 15, cc = c & 31, ob = rr * 64 + cc * 2; return st * 1024 + (ob ^ (((ob >> 9) & 1) << 5)); }
__host__ __device__ __forceinline__ void stage_rc(int b, int& R, int& C) { const int st = b / 1024, sb = b % 1024, swz = sb ^ (((sb >> 9) & 1) << 5); R = (st >> 1) * 16 + swz / 64; C = (st & 1) * 32 + (swz % 64) / 2; }
__host__ __device__ __forceinline__ int perm32(int rho) { const int n = rho >> 4, i = rho & 15; return 8 * (i >> 2) + 4 * n + (i & 3); }

struct Unit { int pm, pn; };
struct Gemm { const bf16_t* A; const bf16_t* Bt; int M, N, K; };

struct StaticOrder {
    int nM, nN, nwg, G, c;
    __host__ __device__ void init(int M, int N, int G_, int c_) { nM = M / BM; nN = N / BM; nwg = nM * nN; G = G_; c = c_; }
    __host__ __device__ bool next(int i, Unit& u) const {
        const long L = (long)i * G + c; if (L >= nwg) return false;
        int wgid = (int)L; { const int q = nwg / NXCD, r = nwg % NXCD, xcd = wgid % NXCD, off = wgid / NXCD; wgid = (xcd < r ? xcd * (q + 1) : r * (q + 1) + (xcd - r) * q) + off; }
        const int nig = WGM * nN, gid = wgid / nig, fm = gid * WGM, gsz = (nM - fm) < WGM ? (nM - fm) : WGM;
        u.pm = fm + ((wgid % nig) % gsz); u.pn = (wgid % nig) / gsz; return true;
    }
    __device__ __forceinline__ void a_ready(const Unit&) const {}
    __device__ __forceinline__ void done(const Unit&) const {}
};

__device__ __forceinline__ unsigned cvt_pk_bf16(float lo, float hi) { unsigned r; asm volatile("v_cvt_pk_bf16_f32 %0, %1, %2" : "=v"(r) : "v"(lo), "v"(hi)); return r; }
typedef float f32x2 __attribute__((ext_vector_type(2)));

typedef float f32x2v __attribute__((ext_vector_type(2)));
typedef __bf16 bf16x2v __attribute__((ext_vector_type(2)));
__device__ __forceinline__ unsigned pkbf(float lo, float hi) { f32x2v v = {lo, hi}; bf16x2v b = __builtin_convertvector(v, bf16x2v); return __builtin_bit_cast(unsigned, b); }
__device__ __forceinline__ float silu_f(float x) { return x * __builtin_amdgcn_rcpf(1.0f + __expf(-x)); }
__device__ __forceinline__ u32x4 pack8(const f32x4& v0, const f32x4& v1) { u32x4 w; w.x = pkbf(v0[0], v0[1]); w.y = pkbf(v0[2], v0[3]); w.z = pkbf(v1[0], v1[1]); w.w = pkbf(v1[2], v1[3]); return w; }

struct EpiBf16 {
    static constexpr bool PERM = true, AFTER_DRAIN = false;
    bf16_t* O; int ldc; int cmask;
    __device__ __forceinline__ void operator()(const f32x4 (&acc)[2][2][4][2], const Unit& u, int wr, int wc, int fr, int fq) const {
        const int row0 = u.pm * BM + wr * 64 + fr, col0 = (u.pn & cmask) * BM + wc * 32 + 8 * fq;
#pragma unroll
        for (int ai = 0; ai < 2; ++ai)
#pragma unroll
            for (int m = 0; m < 4; ++m) { bf16_t* rowp = O + (size_t)(row0 + ai * HALF + m * 16) * ldc + col0;
#pragma unroll
                for (int bj = 0; bj < 2; ++bj) *(u32x4*)(rowp + bj * HALF) = pack8(acc[ai][bj][m][0], acc[ai][bj][m][1]); }
    }
};
struct EpiFp8 {
    static constexpr bool PERM = true, AFTER_DRAIN = false;
    unsigned char* O; int ldc; int cmask;
    __device__ __forceinline__ void operator()(const f32x4 (&acc)[2][2][4][2], const Unit& u, int wr, int wc, int fr, int fq) const {
        const int row0 = u.pm * BM + wr * 64 + fr, col0 = (u.pn & cmask) * BM + wc * 64 + 16 * fq;
#pragma unroll
        for (int ai = 0; ai < 2; ++ai)
#pragma unroll
            for (int m = 0; m < 4; ++m) { u32x4 w;
#pragma unroll
                for (int bj = 0; bj < 2; ++bj)
#pragma unroll
                    for (int n = 0; n < 2; ++n) { const f32x4 v = acc[ai][bj][m][n];
                        int t = __builtin_amdgcn_cvt_pk_fp8_f32(v[0], v[1], 0, false); t = __builtin_amdgcn_cvt_pk_fp8_f32(v[2], v[3], t, true); w[2 * bj + n] = (unsigned)t; }
                *(u32x4*)(O + (size_t)(row0 + ai * HALF + m * 16) * ldc + col0) = w; asm volatile("" ::: "memory"); }
    }
};
struct OneUnit {
    int pm, pn;
    __device__ __forceinline__ bool next(int i, Unit& u) const { if (i) return false; u.pm = pm; u.pn = pn; return true; }
    __device__ __forceinline__ void a_ready(const Unit&) const {}
    __device__ __forceinline__ void done(const Unit&) const {}
};
struct EpiResid {
    static constexpr bool PERM = true, AFTER_DRAIN = false;
    const float* x; float* out; const float* gate;
    __device__ __forceinline__ void operator()(const f32x4 (&acc)[2][2][4][2], const Unit& u, int wr, int wc, int fr, int fq) const {
        const int row0 = u.pm * BM + wr * 64 + fr, col0 = u.pn * BM + wc * 32 + 8 * fq;
        const float* gp = gate + (size_t)((u.pm * BM) >> 12) * 6144 + col0;
        f32x4 gv[2][2];
#pragma unroll
        for (int bj = 0; bj < 2; ++bj)
#pragma unroll
            for (int n = 0; n < 2; ++n) gv[bj][n] = *(const f32x4*)(gp + bj * HALF + 4 * n);
#pragma unroll
        for (int ai = 0; ai < 2; ++ai)
#pragma unroll
            for (int m = 0; m < 4; ++m) { const size_t off = (size_t)(row0 + ai * HALF + m * 16) * 1024 + col0;
#pragma unroll
                for (int bj = 0; bj < 2; ++bj)
#pragma unroll
                    for (int n = 0; n < 2; ++n) { const f32x4 xv = *(const f32x4*)(x + off + bj * HALF + 4 * n); *(f32x4*)(out + off + bj * HALF + 4 * n) = xv + gv[bj][n] * acc[ai][bj][m][n]; } }
    }
};
__device__ __forceinline__ void store_gateup(const f32x4 (&acc)[2][2][4][2], bf16_t* hid, int row0, int j, int wc, int fq) {
#pragma unroll
    for (int ai = 0; ai < 2; ++ai)
#pragma unroll
        for (int m = 0; m < 4; ++m) { f32x4 h0, h1;
#pragma unroll
            for (int e = 0; e < 4; ++e) { h0[e] = silu_f(acc[ai][0][m][0][e]) * acc[ai][1][m][0][e]; h1[e] = silu_f(acc[ai][0][m][1][e]) * acc[ai][1][m][1][e]; }
            *(u32x4*)(hid + (size_t)(row0 + ai * HALF + m * 16) * 256 + 128 * j + wc * 32 + 8 * fq) = pack8(h0, h1); asm volatile("" ::: "memory"); }
}
struct EpiRouterShared {
    static constexpr bool PERM = true, AFTER_DRAIN = false;
    float* logits; bf16_t* hid;
    __device__ __forceinline__ void operator()(const f32x4 (&acc)[2][2][4][2], const Unit& u, int wr, int wc, int fr, int fq) const {
        const int row0 = u.pm * BM + wr * 64 + fr;
        if (u.pn == 0) {
#pragma unroll
            for (int ai = 0; ai < 2; ++ai)
#pragma unroll
                for (int m = 0; m < 4; ++m) { float* rowp = logits + (size_t)(row0 + ai * HALF + m * 16) * 256 + wc * 32 + 8 * fq;
#pragma unroll
                    for (int bj = 0; bj < 2; ++bj)
#pragma unroll
                        for (int n = 0; n < 2; ++n) *(f32x4*)(rowp + bj * HALF + 4 * n) = acc[ai][bj][m][n]; }
        } else store_gateup(acc, hid, row0, u.pn - 1, wc, fq);
    }
};
struct EpiRouterHalf {
    static constexpr bool PERM = true, AFTER_DRAIN = false;
    float* logits;
    __device__ __forceinline__ void operator()(const f32x4 (&acc)[2][2][4][2], const Unit& u, int wr, int wc, int fr, int fq) const {
#pragma unroll
        for (int m = 0; m < 4; ++m) { float* rowp = logits + (size_t)(u.pm * BM + wr * 64 + fr + m * 16) * 256 + wc * 32 + 8 * fq;
#pragma unroll
            for (int bj = 0; bj < 2; ++bj)
#pragma unroll
                for (int n = 0; n < 2; ++n) *(f32x4*)(rowp + bj * HALF + 4 * n) = acc[0][bj][m][n]; }
    }
};
struct EpiGateUp {
    static constexpr bool PERM = true, AFTER_DRAIN = false;
    bf16_t* hid;
    __device__ __forceinline__ void operator()(const f32x4 (&acc)[2][2][4][2], const Unit& u, int wr, int wc, int fr, int fq) const {
        store_gateup(acc, hid, u.pm * BM + wr * 64 + fr, u.pn & 1, wc, fq);
    }
};
struct EpiDownScatter {
    static constexpr bool PERM = true, AFTER_DRAIN = false;
    bf16_t* y; const int* rowdst; const float* roww;
    __device__ __forceinline__ void operator()(const f32x4 (&acc)[2][2][4][2], const Unit& u, int wr, int wc, int fr, int fq) const {
        const int row0 = u.pm * BM + wr * 64 + fr, col0 = (u.pn & 3) * BM + wc * 32 + 8 * fq;
#pragma unroll
        for (int ai = 0; ai < 2; ++ai) {
            int d[4]; float w[4];
#pragma unroll
            for (int m = 0; m < 4; ++m) { const int p = row0 + ai * HALF + m * 16; d[m] = rowdst[p]; w[m] = roww[p]; }
#pragma unroll
            for (int m = 0; m < 4; ++m) { bf16_t* rowp = y + (size_t)d[m] * 1024 + col0;
#pragma unroll
                for (int bj = 0; bj < 2; ++bj) *(u32x4*)(rowp + bj * HALF) = pack8(acc[ai][bj][m][0] * w[m], acc[ai][bj][m][1] * w[m]); }
            asm volatile("" ::: "memory"); }
    }
};

struct EpiResidNorm {
    static constexpr bool PERM = true, AFTER_DRAIN = true;
    const float* x; float* out; const float* mod  ; bf16_t* h2; float* slots  ; unsigned* cnt  ; float eps;
    __device__ __forceinline__ void operator()(const f32x4 (&)[2][2][4][2], const Unit&, int, int, int, int) const {}
    __device__ __forceinline__ void fused(f32x4 (&acc)[2][2][4][2], const Unit& u, int wr, int wc, int fr, int fq, PG8_LAS unsigned char* lds, int wid, int lane) const {
        PG8_LAS float* P = (PG8_LAS float*)lds;
        PG8_LAS float* Sv = (PG8_LAS float*)(lds + 4096);
        const int row0 = u.pm * BM + wr * 64 + fr, col0 = u.pn * BM + wc * 32 + 8 * fq;
        const float* mb = mod + (size_t)((u.pm * BM) >> 12) * 6144;
        {
            f32x4 gv[2][2];
#pragma unroll
            for (int bj = 0; bj < 2; ++bj)
#pragma unroll
                for (int n = 0; n < 2; ++n) gv[bj][n] = *(const f32x4*)(mb + 2048 + col0 + bj * HALF + 4 * n);
            f32x4 xb[2][2][2];
#pragma unroll
            for (int bj = 0; bj < 2; ++bj)
#pragma unroll
                for (int n = 0; n < 2; ++n) xb[0][bj][n] = *(const f32x4*)(x + (size_t)row0 * 1024 + col0 + bj * HALF + 4 * n);
#pragma unroll
            for (int blk = 0; blk < 8; ++blk) { const int ai = blk >> 2, m = blk & 3; const size_t off = (size_t)(row0 + ai * HALF + m * 16) * 1024 + col0; float s = 0.f;
                if (blk < 7) { const size_t offn = (size_t)(row0 + ((blk + 1) >> 2) * HALF + ((blk + 1) & 3) * 16) * 1024 + col0;
#pragma unroll
                    for (int bj = 0; bj < 2; ++bj)
#pragma unroll
                        for (int n = 0; n < 2; ++n) xb[(blk + 1) & 1][bj][n] = *(const f32x4*)(x + offn + bj * HALF + 4 * n); }
#pragma unroll
                for (int bj = 0; bj < 2; ++bj) {
#pragma unroll
                    for (int n = 0; n < 2; ++n) { const f32x4 v = xb[blk & 1][bj][n] + gv[bj][n] * acc[ai][bj][m][n]; acc[ai][bj][m][n] = v;
                        s += (v[0] * v[0] + v[1] * v[1]) + (v[2] * v[2] + v[3] * v[3]); }
                    *(u32x4*)((bf16_t*)out + 2 * (off - col0) + col0 + bj * HALF) = pack8(acc[ai][bj][m][0], acc[ai][bj][m][1]); }
                s += __shfl_xor(s, 16); s += __shfl_xor(s, 32);
                if (fq == 0) P[(ai * HALF + wr * 64 + m * 16 + fr) * 4 + wc] = s; }
        }
        asm volatile("s_waitcnt lgkmcnt(0)" ::: "memory"); __builtin_amdgcn_s_barrier(); asm volatile("" ::: "memory");
        const int row = wid * 32 + (lane & 31);
        if (lane < 32) { const float tot = (P[row * 4 + 0] + P[row * 4 + 1]) + (P[row * 4 + 2] + P[row * 4 + 3]);
            __hip_atomic_store(slots + (size_t)(u.pm * BM + row) * 4 + u.pn, tot, __ATOMIC_RELAXED, __HIP_MEMORY_SCOPE_AGENT); }
        asm volatile("s_waitcnt vmcnt(0)" ::: "memory");
        if (lane == 0) __hip_atomic_fetch_add(cnt + 64 * u.pm, 1u, __ATOMIC_RELAXED, __HIP_MEMORY_SCOPE_AGENT);
        if (wid == 0) {
            unsigned spins = 0;
            while ((unsigned)__builtin_amdgcn_readfirstlane((int)__hip_atomic_load(cnt + 64 * u.pm, __ATOMIC_RELAXED, __HIP_MEMORY_SCOPE_AGENT)) < 32u) { __builtin_amdgcn_s_sleep(2); if (++spins > (1u << 22)) break; }
            __builtin_amdgcn_fence(__ATOMIC_ACQUIRE, "agent");
            asm volatile("s_waitcnt vmcnt(0)" ::: "memory");
        }
        asm volatile("s_waitcnt vmcnt(0) lgkmcnt(0)" ::: "memory"); __builtin_amdgcn_s_barrier(); asm volatile("" ::: "memory");
        if (lane < 32) { const float* sl = slots + (size_t)(u.pm * BM + row) * 4; float t4[4];
#pragma unroll
            for (int t = 0; t < 4; ++t) t4[t] = __hip_atomic_load(sl + t, __ATOMIC_RELAXED, __HIP_MEMORY_SCOPE_AGENT);
            Sv[row] = 1.0f / sqrtf(((t4[0] + t4[1]) + (t4[2] + t4[3])) * (1.0f / 1024.0f) + eps); }
        asm volatile("s_waitcnt lgkmcnt(0)" ::: "memory"); __builtin_amdgcn_s_barrier(); asm volatile("" ::: "memory");
        f32x4 shv[2][2], scv[2][2];
#pragma unroll
        for (int bj = 0; bj < 2; ++bj)
#pragma unroll
            for (int n = 0; n < 2; ++n) { shv[bj][n] = *(const f32x4*)(mb + 3072 + col0 + bj * HALF + 4 * n); scv[bj][n] = *(const f32x4*)(mb + 4096 + col0 + bj * HALF + 4 * n) + 1.0f; }
#pragma unroll
        for (int ai = 0; ai < 2; ++ai)
#pragma unroll
            for (int m = 0; m < 4; ++m) { const int r = ai * HALF + wr * 64 + m * 16 + fr; const float rs = Sv[r]; bf16_t* rowp = h2 + (size_t)(u.pm * BM + r) * 1024 + col0;
#pragma unroll
                for (int bj = 0; bj < 2; ++bj) *(u32x4*)(rowp + bj * HALF) = pack8(acc[ai][bj][m][0] * rs * scv[bj][0] + shv[bj][0], acc[ai][bj][m][1] * rs * scv[bj][1] + shv[bj][1]); }
    }
};
struct RoundSched {
    StaticOrder base; int round;
    __device__ __forceinline__ bool next(int i, Unit& u) const { if (i) return false; return base.next(round, u); }
    __device__ __forceinline__ void a_ready(const Unit&) const {}
    __device__ __forceinline__ void done(const Unit&) const {}
};
struct TileSched {
    const PG8_LAS unsigned short* tile_exp; int first, step, hi, sh;
    __device__ __forceinline__ bool next(int i, Unit& u) const {
        const int L = first + step * i; if (L >= hi) return false;
        const int pm = L >> sh; u.pm = pm; u.pn = (__builtin_amdgcn_readfirstlane((int)tile_exp[pm]) << sh) + (L & ((1 << sh) - 1)); return true;
    }
    __device__ __forceinline__ void a_ready(const Unit&) const {}
    __device__ __forceinline__ void done(const Unit&) const {}
};

template <class Epi, class Sched, bool ALIGN_EPI = false, bool SP2 = false, bool GATHER = false, bool HALFM = false>
__device__ __forceinline__ void gemm_phase(PG8_LAS unsigned char* lds, const Gemm g, const Sched& S, const Epi& E, const unsigned short* glist = nullptr, int gcnt = 0) {
    const int tid = threadIdx.x, wid = __builtin_amdgcn_readfirstlane(tid >> 6), lane = tid & 63, wr = wid >> 2, wc = wid & 3, fr = lane & 15, fq = lane >> 4;
    const int K = g.K, nt = K / BK;
    unsigned voffA[2], voffA1[2], voffB[2];
#pragma unroll
    for (int i = 0; i < 2; ++i) { int R, C; stage_rc(tid * 16 + i * 8192, R, C); const int Rb = Epi::PERM ? ((R & ~31) + perm32(R & 31)) : R;
        voffA[i] = (unsigned)(R * K + C) * 2u; voffA1[i] = voffA[i]; voffB[i] = (unsigned)(Rb * K + C) * 2u;
        if constexpr (GATHER) {
            const int ra = R < gcnt ? (int)glist[R] : 0, rb = (HALF + R) < gcnt ? (int)glist[HALF + R] : 0;
            voffA[i] = (unsigned)(ra * K + C) * 2u; voffA1[i] = (unsigned)(rb * K + C) * 2u; } }
    const size_t kstep = (size_t)(BK * 2);
    const size_t hstep = (size_t)HALF * K * 2;
    const size_t tstep = 2 * hstep;
    const size_t hstepA = GATHER ? 0 : hstep, tstepA = GATHER ? 0 : tstep;
    const unsigned ldsw = (unsigned)wid * 1024u;
    const int aoff = lds_byte(wr * 64 + fr, fq * 8), boff = lds_byte(wc * 32 + fr, fq * 8);
#define PG8_SA(b, h) (((b) * 2 + (h)) * HTB)
#define PG8_SB(b, h) ((4 + (b) * 2 + (h)) * HTB)
#define PG8_STAGE(bufoff, gbase, voff) do { _Pragma("unroll") for (int _i = 0; _i < 2; ++_i) \
        __builtin_amdgcn_global_load_lds((const unsigned*)((const char*)(gbase) + (voff)[_i]), (PG8_LAS unsigned*)(lds + (bufoff) + ldsw + _i * 8192), 16, 0, 0); } while (0)
#define PG8_LDA(dst, b, h) do { _Pragma("unroll") for (int m = 0; m < 4; ++m) _Pragma("unroll") for (int k = 0; k < 2; ++k) dst[m][k] = *(const PG8_LAS bf16x8*)(lds + PG8_SA(b, h) + aoff + m * 2048 + k * 1024); } while (0)
#define PG8_LDB(dst, b, h) do { _Pragma("unroll") for (int n = 0; n < 2; ++n) _Pragma("unroll") for (int k = 0; k < 2; ++k) dst[n][k] = *(const PG8_LAS bf16x8*)(lds + PG8_SB(b, h) + boff + n * 2048 + k * 1024); } while (0)
#define PG8_MMA(ai, bj, At, Bt) do { __builtin_amdgcn_s_setprio(1); _Pragma("unroll") for (int m = 0; m < 4; ++m) _Pragma("unroll") for (int n = 0; n < 2; ++n) _Pragma("unroll") for (int k = 0; k < 2; ++k) \
        acc[ai][bj][m][n] = __builtin_amdgcn_mfma_f32_16x16x32_bf16(Bt[n][k], At[m][k], acc[ai][bj][m][n], 0, 0, 0); __builtin_amdgcn_s_setprio(0); } while (0)
#define PG8_WAIT_V(n) asm volatile("s_waitcnt vmcnt(" #n ")" ::: "memory")
#define PG8_WAIT_L(n) asm volatile("s_waitcnt lgkmcnt(" #n ")" ::: "memory")
#define PG8_BAR __builtin_amdgcn_s_barrier()
#define PG8_SCHED __builtin_amdgcn_sched_barrier(0)
    Unit cur, nxt; int ui = 0;
    if (!S.next(0, cur)) return;
    f32x4 acc[2][2][4][2];
#pragma unroll
    for (int a = 0; a < 2; ++a)
#pragma unroll
        for (int b = 0; b < 2; ++b)
#pragma unroll
            for (int m = 0; m < 4; ++m)
#pragma unroll
                for (int n = 0; n < 2; ++n) acc[a][b][m][n] = (f32x4){0.f, 0.f, 0.f, 0.f};
    bf16x8 At[4][2], B0[2][2], B1[2][2];
    const char* cA = (const char*)g.A + (size_t)cur.pm * tstepA; const char* cB = (const char*)g.Bt + (size_t)cur.pn * tstep;
    S.a_ready(cur);
    if constexpr (SP2) {
        PG8_STAGE(PG8_SB(0, 0), cB, voffB); PG8_STAGE(PG8_SB(0, 1), cB + hstep, voffB); PG8_STAGE(PG8_SA(0, 0), cA, voffA); PG8_STAGE(PG8_SA(0, 1), cA + hstepA, voffA1);
        if (wr == 1) PG8_BAR;
        PG8_WAIT_V(2); PG8_BAR;
        PG8_STAGE(PG8_SB(1, 0), cB + kstep, voffB); PG8_STAGE(PG8_SA(1, 0), cA + kstep, voffA); PG8_STAGE(PG8_SB(1, 1), cB + hstep + kstep, voffB);
        PG8_WAIT_V(6); PG8_BAR;
    } else {
        PG8_STAGE(PG8_SB(0, 0), cB, voffB); PG8_STAGE(PG8_SA(0, 0), cA, voffA); PG8_STAGE(PG8_SB(0, 1), cB + hstep, voffB); PG8_STAGE(PG8_SA(0, 1), cA + hstepA, voffA1);
        if (wr == 1) PG8_BAR;
        PG8_WAIT_V(4); PG8_BAR;
        PG8_STAGE(PG8_SB(1, 0), cB + kstep, voffB); PG8_STAGE(PG8_SA(1, 0), cA + kstep, voffA); PG8_STAGE(PG8_SB(1, 1), cB + hstep + kstep, voffB);
        PG8_WAIT_V(6); PG8_BAR;
    }
    for (;;) {
        const bool has_next = S.next(ui + 1, nxt);
        const char* nA = has_next ? (const char*)g.A + (size_t)nxt.pm * tstepA : cA; const char* nB = has_next ? (const char*)g.Bt + (size_t)nxt.pn * tstep : cB;
#pragma nounroll
        for (int t = 0; t < nt; t += 2) {
            const bool last = (t == nt - 2);
            const char* a1 = cA + (size_t)(t + 1) * kstep;
            const char* a2 = last ? nA : cA + (size_t)(t + 2) * kstep; const char* b2 = last ? nB : cB + (size_t)(t + 2) * kstep;
            const char* a3 = a2 + kstep; const char* b3 = b2 + kstep;
            if (last && has_next) S.a_ready(nxt);
            if constexpr (SP2) {
            PG8_LDB(B0, 0, 0); PG8_LDB(B1, 0, 1); PG8_SCHED; PG8_LDA(At, 0, 0); PG8_STAGE(PG8_SA(1, 1), a1 + hstepA, voffA1);
            PG8_WAIT_V(8); PG8_WAIT_L(0); PG8_BAR; PG8_MMA(0, 0, At, B0); PG8_MMA(0, 1, At, B1); PG8_BAR; PG8_SCHED;
            if (!HALFM) PG8_LDA(At, 0, 1); PG8_STAGE(PG8_SB(0, 0), b2, voffB); PG8_STAGE(PG8_SB(0, 1), b2 + hstep, voffB); PG8_STAGE(PG8_SA(0, 0), a2, voffA);
            PG8_WAIT_V(8); PG8_WAIT_L(0); PG8_BAR; if (!HALFM) { PG8_MMA(1, 0, At, B0); PG8_MMA(1, 1, At, B1); } PG8_BAR; PG8_SCHED;
            PG8_LDB(B0, 1, 0); PG8_LDB(B1, 1, 1); PG8_SCHED; PG8_LDA(At, 1, 0); PG8_STAGE(PG8_SA(0, 1), a2 + hstepA, voffA1);
            PG8_WAIT_V(8); PG8_WAIT_L(0); PG8_BAR; PG8_MMA(0, 0, At, B0); PG8_MMA(0, 1, At, B1); PG8_BAR; PG8_SCHED;
            if (!HALFM) PG8_LDA(At, 1, 1); PG8_STAGE(PG8_SB(1, 0), b3, voffB); PG8_STAGE(PG8_SB(1, 1), b3 + hstep, voffB); PG8_STAGE(PG8_SA(1, 0), a3, voffA);
            PG8_WAIT_V(8); PG8_WAIT_L(0); PG8_BAR; if (!HALFM) { PG8_MMA(1, 0, At, B0); PG8_MMA(1, 1, At, B1); } PG8_BAR; PG8_SCHED;
            } else {
            PG8_LDB(B0, 0, 0); PG8_SCHED; PG8_LDA(At, 0, 0); PG8_STAGE(PG8_SA(1, 1), a1 + hstepA, voffA1);
            PG8_WAIT_L(8); PG8_BAR; PG8_WAIT_L(0); PG8_MMA(0, 0, At, B0); PG8_BAR; PG8_SCHED;
            PG8_LDB(B1, 0, 1); PG8_STAGE(PG8_SB(0, 0), b2, voffB);
            PG8_BAR; PG8_WAIT_L(0); PG8_MMA(0, 1, At, B1); PG8_BAR;
            PG8_LDA(At, 0, 1); PG8_STAGE(PG8_SA(0, 0), a2, voffA);
            PG8_BAR; PG8_WAIT_L(0); PG8_MMA(1, 0, At, B0); PG8_BAR; PG8_SCHED;
            PG8_STAGE(PG8_SB(0, 1), b2 + hstep, voffB);
            PG8_WAIT_V(6); PG8_BAR; PG8_MMA(1, 1, At, B1); PG8_BAR;
            PG8_LDB(B0, 1, 0); PG8_SCHED; PG8_LDA(At, 1, 0); PG8_STAGE(PG8_SA(0, 1), a2 + hstepA, voffA1);
            PG8_WAIT_L(8); PG8_BAR; PG8_WAIT_L(0); PG8_MMA(0, 0, At, B0); PG8_BAR; PG8_SCHED;
            PG8_LDB(B1, 1, 1); PG8_STAGE(PG8_SB(1, 0), b3, voffB);
            PG8_BAR; PG8_WAIT_L(0); PG8_MMA(0, 1, At, B1); PG8_BAR;
            PG8_LDA(At, 1, 1); PG8_STAGE(PG8_SA(1, 0), a3, voffA);
            PG8_BAR; PG8_WAIT_L(0); PG8_MMA(1, 0, At, B0); PG8_BAR; PG8_SCHED;
            PG8_STAGE(PG8_SB(1, 1), b3 + hstep, voffB);
            PG8_WAIT_V(6); PG8_BAR; PG8_MMA(1, 1, At, B1); PG8_BAR;
            }
        }
        if constexpr (ALIGN_EPI) { if (wr == 0) PG8_BAR; }
        if constexpr (!Epi::AFTER_DRAIN) { E(acc, cur, wr, wc, fr, fq); S.done(cur); }
        if (!has_next) break;
#pragma unroll
        for (int a = 0; a < 2; ++a)
#pragma unroll
            for (int b = 0; b < 2; ++b)
#pragma unroll
                for (int m = 0; m < 4; ++m)
#pragma unroll
                    for (int n = 0; n < 2; ++n) acc[a][b][m][n] = (f32x4){0.f, 0.f, 0.f, 0.f};
        cur = nxt; cA = nA; cB = nB; ++ui;
        if constexpr (ALIGN_EPI) { if (wr == 1) PG8_BAR; }
    }
    PG8_WAIT_V(0);
    if constexpr (!ALIGN_EPI) { if (wr == 0) PG8_BAR; }
    PG8_BAR;
    if constexpr (Epi::AFTER_DRAIN) { E.fused(acc, cur, wr, wc, fr, fq, lds, wid, lane); S.done(cur); }
#undef PG8_SA
#undef PG8_SB
#undef PG8_STAGE
#undef PG8_LDA
#undef PG8_LDB
#undef PG8_MMA
#undef PG8_WAIT_V
#undef PG8_WAIT_L
#undef PG8_BAR
#undef PG8_SCHED
}

typedef int i32x4 __attribute__((ext_vector_type(4)));
struct MoeStream {
    const unsigned char* h2q; const unsigned char* wgu8; const float* swgu; bf16_t* hid; const unsigned char* hidq; const unsigned char* wd8; const float* swd; unsigned char* y;
    const PG8_LAS unsigned short* texp;
    const PG8_LAS unsigned short* glist;
    const PG8_LAS float* rscale;
    const PG8_LAS unsigned short* tl;
    const PG8_LAS unsigned short* rl;
    int n;
    const PG8_LAS int* dst;
    const PG8_LAS float* lsc;
    StaticOrder order;
};
struct MUnit { int kind, slot, tile, j, e, rows; };
template <int KIND> __device__ __forceinline__ bool moe_next(const MoeStream& S, int q, MUnit& u) {
    if (KIND == 2) { Unit uu; if (!S.order.next(q, uu)) return false; u.kind = 2; u.slot = 0; u.tile = uu.pm; u.j = uu.pn; u.e = 0; u.rows = 256; return true; }
    if (KIND == 0) { if (q >= 2 * S.n) return false; u.kind = 0; u.slot = q >> 1; u.j = q & 1; }
    else { if (q >= 4 * S.n) return false; u.kind = 1; u.slot = q >> 2; u.j = q & 3; }
    u.tile = __builtin_amdgcn_readfirstlane((int)S.tl[u.slot]); u.rows = __builtin_amdgcn_readfirstlane((int)S.rl[u.slot]); u.e = __builtin_amdgcn_readfirstlane((int)S.texp[u.tile]); return true;
}
template <int KIND, int VAR = 0> __device__ __forceinline__ void moe_stream(PG8_LAS unsigned char* lds, const MoeStream S) {
    int tid_ = threadIdx.x; asm volatile("" : "+v"(tid_));
    const int tid = tid_, wid = __builtin_amdgcn_readfirstlane(tid >> 6), lane = tid & 63, wr = wid >> 2, wc = wid & 3, fr = lane & 15, fq = lane >> 4;
    unsigned voffA[2], voffA1[2], voffB[2];
#define MS_OFFS(u) do { int tidv_ = tid; asm volatile("" : "+v"(tidv_)); _Pragma("unroll") for (int i_ = 0; i_ < 2; ++i_) { int sR[2], sC[2], sRb[2]; stage_rc(tidv_ * 16 + i_ * 8192, sR[i_], sC[i_]); sRb[i_] = (sR[i_] & ~31) + perm32(sR[i_] & 31); \
        if (KIND == 2) { voffA[i_] = (unsigned)(sR[i_] * 1024 + sC[i_] * 2); voffA1[i_] = voffA[i_]; voffB[i_] = (unsigned)(sRb[i_] * 1024 + sC[i_] * 2); } \
        else if (KIND == 0) { const PG8_LAS unsigned short* gl_ = S.glist + (u).slot * 256; \
            voffA[i_] = (unsigned)((int)gl_[sR[i_]] * 1024 + sC[i_] * 2); voffA1[i_] = (unsigned)((int)gl_[HALF + sR[i_]] * 1024 + sC[i_] * 2); voffB[i_] = (unsigned)(sRb[i_] * 1024 + sC[i_] * 2); } \
        else { voffA[i_] = (unsigned)(sR[i_] * 256 + sC[i_] * 2); voffA1[i_] = voffA[i_]; voffB[i_] = (unsigned)(sRb[i_] * 256 + sC[i_] * 2); } } } while (0)
#define MS_PARAMS(u, pA, pB, hA, hB, ntv) do { \
        if (KIND == 2) { pA = (const char*)S.h2q + (size_t)(u).tile * (256 * 1024); hA = (unsigned)(HALF * 1024); pB = (const char*)S.wgu8 + (size_t)(u).j * (256 * 1024); hB = (unsigned)(HALF * 1024); ntv = 8; } \
        else if (KIND == 0) { pA = (const char*)S.h2q; hA = 0u; pB = (const char*)S.wgu8 + (size_t)((u).e * 2 + (u).j) * (256 * 1024); hB = (unsigned)(HALF * 1024); ntv = 8; } \
        else { pA = (const char*)S.hidq + (size_t)(u).tile * (256 * 256); hA = (unsigned)(HALF * 256); pB = (const char*)S.wd8 + (size_t)((u).e * 4 + (u).j) * (256 * 256); hB = (unsigned)(HALF * 256); ntv = 2; } } while (0)
    const size_t kstep = (size_t)(BK * 2);
    const unsigned ldsw = (unsigned)wid * 1024u;
    const int aoff = lds_byte(wr * 64 + fr, fq * 8), boff = lds_byte(wc * 32 + fr, fq * 8);
#define PG8_SA(b, h) (((b) * 2 + (h)) * HTB)
#define PG8_SB(b, h) ((4 + (b) * 2 + (h)) * HTB)
#define PG8_STAGE(bufoff, gbase, voff) do { _Pragma("unroll") for (int _i = 0; _i < 2; ++_i) { unsigned vo_ = (voff)[_i]; asm volatile("" : "+v"(vo_));     \
        __builtin_amdgcn_global_load_lds((const unsigned*)((const char*)(gbase) + vo_), (PG8_LAS unsigned*)(lds + (bufoff) + ldsw + _i * 8192), 16, 0, 0); } } while (0)
#define PG8_LDA(dst, b, h) do { _Pragma("unroll") for (int m = 0; m < 4; ++m) _Pragma("unroll") for (int k = 0; k < 2; ++k) dst[m][k] = *(const PG8_LAS bf16x8*)(lds + PG8_SA(b, h) + aoff + m * 2048 + k * 1024); } while (0)
#define PG8_LDB(dst, b, h) do { _Pragma("unroll") for (int n = 0; n < 2; ++n) _Pragma("unroll") for (int k = 0; k < 2; ++k) dst[n][k] = *(const PG8_LAS bf16x8*)(lds + PG8_SB(b, h) + boff + n * 2048 + k * 1024); } while (0)
#define PG8_MMA(ai, bj, At, Bt) do { __builtin_amdgcn_s_setprio(1); _Pragma("unroll") for (int m = 0; m < 4; ++m) _Pragma("unroll") for (int n = 0; n < 2; ++n) _Pragma("unroll") for (int k = 0; k < 2; ++k) \
        acc[ai][bj][m][n] = __builtin_amdgcn_mfma_f32_16x16x32_bf16(Bt[n][k], At[m][k], acc[ai][bj][m][n], 0, 0, 0); __builtin_amdgcn_s_setprio(0); } while (0)
#define PG8_MMA8(ai, bj, At, Bt) do { __builtin_amdgcn_s_setprio(1); _Pragma("unroll") for (int m = 0; m < 4; ++m) _Pragma("unroll") for (int n = 0; n < 2; ++n) _Pragma("unroll") for (int k = 0; k < 2; ++k) \
        acc[ai][bj][m][n] = __builtin_bit_cast(f32x4, __builtin_amdgcn_mfma_i32_16x16x64_i8(__builtin_bit_cast(i32x4, Bt[n][k]), __builtin_bit_cast(i32x4, At[m][k]), __builtin_bit_cast(i32x4, acc[ai][bj][m][n]), 0, 0, 0)); __builtin_amdgcn_s_setprio(0); } while (0)
#define MS_MMA(ai, bj, At, Bt) PG8_MMA8(ai, bj, At, Bt)
#define PG8_WAIT_V(n) asm volatile("s_waitcnt vmcnt(" #n ")" ::: "memory")
#define MS_WAIT_K do { if (KIND == 1) PG8_WAIT_V(4); else PG8_WAIT_V(8); } while (0)
#define PG8_WAIT_L(n) asm volatile("s_waitcnt lgkmcnt(" #n ")" ::: "memory")
#define PG8_BAR __builtin_amdgcn_s_barrier()
#define PG8_SCHED __builtin_amdgcn_sched_barrier(0)
    MUnit cur, nxt; int ui = 0;
    if (!moe_next<KIND>(S, 0, cur)) return;
    f32x4 acc[2][2][4][2];
#pragma unroll
    for (int a = 0; a < 2; ++a)
#pragma unroll
        for (int b = 0; b < 2; ++b)
#pragma unroll
            for (int m = 0; m < 4; ++m)
#pragma unroll
                for (int n = 0; n < 2; ++n) acc[a][b][m][n] = (f32x4){0.f, 0.f, 0.f, 0.f};
    bf16x8 At[4][2], B0[2][2], B1[2][2];
    const char* cA; const char* cB; unsigned chA, chB; int nt;
    MS_PARAMS(cur, cA, cB, chA, chB, nt);
    asm volatile("" : "+s"(nt));
    MS_OFFS(cur);
    PG8_STAGE(PG8_SB(0, 0), cB, voffB); PG8_STAGE(PG8_SB(0, 1), cB + chB, voffB); PG8_STAGE(PG8_SA(0, 0), cA, voffA); PG8_STAGE(PG8_SA(0, 1), cA + chA, voffA1);
    if (wr == 1) PG8_BAR;
    PG8_WAIT_V(2); PG8_BAR;
    PG8_STAGE(PG8_SB(1, 0), cB + kstep, voffB); PG8_STAGE(PG8_SA(1, 0), cA + kstep, voffA); PG8_STAGE(PG8_SB(1, 1), cB + chB + kstep, voffB);
    PG8_WAIT_V(6); PG8_BAR;
    for (;;) {
        const bool has_next = moe_next<KIND>(S, ui + 1, nxt);
        const char* nA = cA; const char* nB = cB; unsigned nhA = chA, nhB = chB; int nnt = nt;
        if (has_next) MS_PARAMS(nxt, nA, nB, nhA, nhB, nnt);
        const bool new_offs = KIND != 2 && has_next && (nxt.kind != cur.kind || nxt.slot != cur.slot);
        const bool stA_cur = KIND != 1 || cur.j == 0, stA_nxt = KIND != 1 || (has_next && nxt.j == 0);
        const bool act0 = VAR != 3 && (KIND == 2 || cur.rows > 64 * wr), act1 = VAR != 3 && (KIND == 2 || cur.rows > 128 + 64 * wr);
#pragma nounroll
        for (int t = 0; t < nt; t += 2) {
            const bool last = (t == nt - 2);
            const char* a1 = cA + (size_t)(t + 1) * kstep;
            const char* a2 = last ? nA : cA + (size_t)(t + 2) * kstep; const char* b2 = last ? nB : cB + (size_t)(t + 2) * kstep;
            const char* a3 = a2 + kstep; const char* b3 = b2 + kstep;
            const unsigned hA2 = last ? nhA : chA, hB2 = last ? nhB : chB;
            if (act0) { PG8_LDB(B0, 0, 0); PG8_LDB(B1, 0, 1); PG8_SCHED; PG8_LDA(At, 0, 0); } if (stA_cur) PG8_STAGE(PG8_SA(1, 1), a1 + chA, voffA1);
            if (last && new_offs) MS_OFFS(nxt);
            MS_WAIT_K; PG8_WAIT_L(0); PG8_BAR; if (act0) { MS_MMA(0, 0, At, B0); MS_MMA(0, 1, At, B1); } PG8_BAR; PG8_SCHED;
            if (act1) PG8_LDA(At, 0, 1); PG8_STAGE(PG8_SB(0, 0), b2, voffB); PG8_STAGE(PG8_SB(0, 1), b2 + hB2, voffB); if (stA_nxt) PG8_STAGE(PG8_SA(0, 0), a2, voffA);
            MS_WAIT_K; PG8_WAIT_L(0); PG8_BAR; if (act1) { MS_MMA(1, 0, At, B0); MS_MMA(1, 1, At, B1); } PG8_BAR; PG8_SCHED;
            if (act0) { PG8_LDB(B0, 1, 0); PG8_LDB(B1, 1, 1); PG8_SCHED; PG8_LDA(At, 1, 0); } if (stA_nxt) PG8_STAGE(PG8_SA(0, 1), a2 + hA2, voffA1);
            MS_WAIT_K; PG8_WAIT_L(0); PG8_BAR; if (act0) { MS_MMA(0, 0, At, B0); MS_MMA(0, 1, At, B1); } PG8_BAR; PG8_SCHED;
            if (act1) PG8_LDA(At, 1, 1); PG8_STAGE(PG8_SB(1, 0), b3, voffB); PG8_STAGE(PG8_SB(1, 1), b3 + hB2, voffB); if (stA_nxt) PG8_STAGE(PG8_SA(1, 0), a3, voffA);
            MS_WAIT_K; PG8_WAIT_L(0); PG8_BAR; if (act1) { MS_MMA(1, 0, At, B0); MS_MMA(1, 1, At, B1); } PG8_BAR; PG8_SCHED;
        }
        if (wr == 0) PG8_BAR;
        if constexpr (KIND == 2) {
            const int ncols = S.order.nN * BM;
            const float* swp = S.swgu + cur.j * BM + wc * 32 + 8 * fq;
            f32x4 sw[2][2];
#pragma unroll
            for (int bj = 0; bj < 2; ++bj)
#pragma unroll
                for (int n = 0; n < 2; ++n) sw[bj][n] = *(const f32x4*)(swp + bj * HALF + 4 * n);
            const float* rsg = S.swd + cur.tile * BM + wr * 64 + fr;
            float rsv[2][4];
#pragma unroll
            for (int ai = 0; ai < 2; ++ai)
#pragma unroll
                for (int m = 0; m < 4; ++m) rsv[ai][m] = rsg[ai * HALF + m * 16];
            bf16_t* orow = S.hid + (size_t)(cur.tile * BM + wr * 64 + fr) * ncols + cur.j * BM + wc * 32 + 8 * fq;
#pragma unroll
            for (int ai = 0; ai < 2; ++ai)
#pragma unroll
                for (int m = 0; m < 4; ++m) { const float rs = rsv[ai][m];
#pragma unroll
                    for (int bj = 0; bj < 2; ++bj) { const i32x4 i0 = __builtin_bit_cast(i32x4, acc[ai][bj][m][0]), i1 = __builtin_bit_cast(i32x4, acc[ai][bj][m][1]); f32x4 v0, v1;
#pragma unroll
                        for (int e4 = 0; e4 < 4; ++e4) { v0[e4] = (float)i0[e4] * (rs * sw[bj][0][e4]); v1[e4] = (float)i1[e4] * (rs * sw[bj][1][e4]); }
                        *(u32x4*)(orow + (size_t)(ai * HALF + m * 16) * ncols + bj * HALF) = pack8(v0, v1); }
                    asm volatile("" ::: "memory"); }
        } else if constexpr (VAR >= 2) {
            if (VAR == 2) {
#pragma unroll
                for (int a_ = 0; a_ < 2; ++a_)
#pragma unroll
                    for (int b_ = 0; b_ < 2; ++b_)
#pragma unroll
                        for (int m_ = 0; m_ < 4; ++m_)
#pragma unroll
                            for (int n_ = 0; n_ < 2; ++n_) asm volatile("" :: "v"(acc[a_][b_][m_][n_])); }
        } else if constexpr (KIND == 0) {
            const PG8_LAS float* swp = S.lsc + cur.slot * 512 + cur.j * 256 + wc * 32 + 8 * fq;
            const f32x4 sg0 = *(const PG8_LAS f32x4*)swp, sg1 = *(const PG8_LAS f32x4*)(swp + 4), su0 = *(const PG8_LAS f32x4*)(swp + HALF), su1 = *(const PG8_LAS f32x4*)(swp + HALF + 4);
            asm volatile("" :: "v"(sg0), "v"(sg1), "v"(su0), "v"(su1));
            const PG8_LAS float* rsp = S.rscale + cur.slot * 256 + wr * 64 + fr;
            bf16_t* hrow = S.hid + (size_t)(cur.tile * BM + wr * 64 + fr) * 256 + 128 * cur.j + wc * 32 + 8 * fq;
#pragma unroll
            for (int ai = 0; ai < 2; ++ai)
#pragma unroll
                for (int m = 0; m < 4; ++m) { if (cur.rows <= ai * HALF + wr * 64 + m * 16) continue;
                    const float rs = rsp[ai * HALF + m * 16]; f32x4 h0, h1;
                    { const i32x4 gi = __builtin_bit_cast(i32x4, acc[ai][0][m][0]), ui = __builtin_bit_cast(i32x4, acc[ai][1][m][0]);
#pragma unroll
                        for (int e4 = 0; e4 < 4; ++e4) h0[e4] = silu_f((float)gi[e4] * (rs * sg0[e4])) * ((float)ui[e4] * (rs * su0[e4])); }
                    { const i32x4 gi = __builtin_bit_cast(i32x4, acc[ai][0][m][1]), ui = __builtin_bit_cast(i32x4, acc[ai][1][m][1]);
#pragma unroll
                        for (int e4 = 0; e4 < 4; ++e4) h1[e4] = silu_f((float)gi[e4] * (rs * sg1[e4])) * ((float)ui[e4] * (rs * su1[e4])); }
                    if (VAR == 0) *(u32x4*)(hrow + (size_t)(ai * HALF + m * 16) * 256) = pack8(h0, h1); else { u32x4 pk_ = pack8(h0, h1); asm volatile("" :: "v"(pk_)); } asm volatile("" ::: "memory"); }
        }
        else {
            const float swv = S.lsc[cur.slot * 8 + cur.j * 2 + (wc >> 1)];
            asm volatile("" :: "v"(swv));
            const PG8_LAS float* rsp = S.rscale + cur.slot * 256 + wr * 64 + fr;
            unsigned char* ycol = S.y + cur.j * BM + wc * 64 + 16 * fq; const PG8_LAS int* dsp = S.dst + cur.slot * 256 + wr * 64 + fr;
#pragma unroll
            for (int ai = 0; ai < 2; ++ai)
#pragma unroll
                for (int m = 0; m < 4; ++m) { if (cur.rows <= ai * HALF + wr * 64 + m * 16) continue;
                    const float rs = rsp[ai * HALF + m * 16] * swv; u32x4 w;
#pragma unroll
                    for (int bj = 0; bj < 2; ++bj)
#pragma unroll
                        for (int n = 0; n < 2; ++n) { const i32x4 vi = __builtin_bit_cast(i32x4, acc[ai][bj][m][n]);
                            int t = __builtin_amdgcn_cvt_pk_fp8_f32((float)vi[0] * rs, (float)vi[1] * rs, 0, false); t = __builtin_amdgcn_cvt_pk_fp8_f32((float)vi[2] * rs, (float)vi[3] * rs, t, true); w[2 * bj + n] = (unsigned)t; }
                    const int d_ = dsp[ai * HALF + m * 16]; if (VAR == 0) { if (d_ >= 0) *(u32x4*)(ycol + (size_t)d_ * 1024) = w; } else asm volatile("" :: "v"(w), "v"(d_)); asm volatile("" ::: "memory"); }
        }
        if (!has_next) break;
#pragma unroll
        for (int a = 0; a < 2; ++a)
#pragma unroll
            for (int b = 0; b < 2; ++b)
#pragma unroll
                for (int m = 0; m < 4; ++m)
#pragma unroll
                    for (int n = 0; n < 2; ++n) acc[a][b][m][n] = (f32x4){0.f, 0.f, 0.f, 0.f};
        cur = nxt; cA = nA; cB = nB; chA = nhA; chB = nhB; nt = nnt; ++ui;
        if (wr == 1) PG8_BAR;
    }
    PG8_WAIT_V(0);
    PG8_BAR;
#undef MS_OFFS
#undef MS_WAIT_K
#undef MS_MMA
#undef PG8_MMA8
#undef MS_PARAMS
#undef PG8_SA
#undef PG8_SB
#undef PG8_STAGE
#undef PG8_LDA
#undef PG8_LDB
#undef PG8_MMA
#undef PG8_WAIT_V
#undef PG8_WAIT_L
#undef PG8_BAR
#undef PG8_SCHED
}


}

#ifndef MK_MULTI
#define MK_MULTI 0
#endif
constexpr int NWAVES = 8, NTHR = 512;
constexpr int D = 1024, NB = 8, SEQ = 4096, T = NB * SEQ;
constexpr int QC = 512, KVC = 128, CC = 512, INC = 1792;
constexpr int NE = 256, TOPK = 8, EH = 256, CW = 31;
constexpr int NEX = NE + 1;
constexpr int NSLOT = TOPK + 1;
constexpr int PMAX = T * TOPK + T + NEX * 256;
constexpr int MAXTILES = PMAX / 256;
constexpr float EPS = 1e-6f;
constexpr int NPHASE = 12;
constexpr size_t MiB = 1u << 20;
constexpr size_t WS_CTL = 0, CTL_ZERO_BYTES = 1 * MiB;
constexpr size_t WS_MOD = 1 * MiB;
constexpr size_t WS_ROWTOK = 2 * MiB, WS_ROWDST = WS_ROWTOK + (size_t)PMAX * 4, WS_ROWW = WS_ROWDST + (size_t)PMAX * 4;
constexpr size_t WS_EIDX = 6 * MiB, WS_GW = 7 * MiB, WS_POS = 8 * MiB;
constexpr size_t WS_WIN = 10 * MiB;
constexpr size_t WS_WOUT = 14 * MiB;
constexpr size_t WS_WRS = 16 * MiB;
constexpr size_t WS_WSHD = 18 * MiB;
constexpr size_t WS_WD = 20 * MiB;
constexpr size_t WS_LOGITS = 148 * MiB;
constexpr size_t WS_HIDSH = 180 * MiB;
constexpr size_t WS_HID = 148 * MiB;
constexpr size_t WS_H = 356 * MiB;
constexpr size_t WS_WGU = 420 * MiB;
constexpr size_t WS_H2Q = 549 * MiB;
constexpr size_t WS_SWGU = 2 * MiB;
constexpr size_t WS_SA = 3 * MiB;
constexpr size_t WS_WSHQ = 5 * MiB;
constexpr size_t WS_SWSH = 4 * MiB + 65536;
constexpr size_t WS_WINQ = 10 * MiB;
constexpr size_t WS_SWIN = 4 * MiB + 131072;
constexpr size_t WS_SA1 = 3 * MiB + 262144;
constexpr size_t WS_SWD = 4 * MiB;
constexpr size_t WS_HIDQ = 581 * MiB;
constexpr size_t WS_Y = 676 * MiB;
constexpr size_t WS_PROJ = 676 * MiB;
constexpr size_t WS_CAT = 788 * MiB;
constexpr size_t WS_LIST = 996 * MiB;
constexpr size_t WS_SLOT = 1012 * MiB;
constexpr size_t WS_END = 1020 * MiB;
static_assert(WS_HID + (size_t)PMAX * 512 <= WS_H && WS_LOGITS >= WS_WD + (size_t)NEX * 1024 * 256 && WS_H + (size_t)T * D * 2 <= WS_WGU && WS_WGU + (size_t)NEX * 512 * 1024 <= WS_H2Q && WS_H2Q + (size_t)T * D <= WS_HIDQ && WS_HIDQ + (size_t)PMAX * 256 <= WS_Y && WS_Y + (size_t)(T * NSLOT + 1) * 1024 <= WS_LIST && WS_LIST + (size_t)NE * T * 2 <= WS_SLOT && WS_SLOT + (size_t)NE * T <= WS_END && WS_PROJ + (size_t)T * INC * 2 <= WS_END, "d_ws map");
constexpr size_t WS_NEED = WS_END;
constexpr int CW_BAR = 4096;
constexpr int CW_COUNTS = 8192;
constexpr int CW_PANEL = 32768;
constexpr int CW_SHQ = 1024;
constexpr int RING_BYTES = 131072;
constexpr int LX_MISC = RING_BYTES;
constexpr int LX_BASE = RING_BYTES + 256;
constexpr int LX_TEXP = LX_BASE + 1040;
constexpr int LX_CNT = LX_TEXP + 2880;
constexpr int LX_GL = LX_CNT + 1040;
constexpr int LX_RS = LX_GL + 6 * 512;
constexpr int LX_DST = LX_RS + 6 * 1024;
constexpr int LX_MY = LX_DST + 6 * 2048;
constexpr int LX_FT = LX_MY + 256;
constexpr int LX_CT = LX_FT + 2880;
constexpr int LDS_BYTES = 161792;
static_assert(LX_CT + 528 <= LDS_BYTES, "LDS map");

#define GAS __attribute__((address_space(1)))
#define LAS __attribute__((address_space(3)))
typedef unsigned short bf16;
typedef unsigned v4u __attribute__((ext_vector_type(4)));
typedef unsigned v2u __attribute__((ext_vector_type(2)));
typedef float f32x4 __attribute__((ext_vector_type(4)));
typedef float f32x16 __attribute__((ext_vector_type(16)));
typedef short bf16x8 __attribute__((ext_vector_type(8)));
typedef short s16x4 __attribute__((ext_vector_type(4)));
typedef GAS unsigned gu32;
#define RLX_AGENT __ATOMIC_RELAXED, __HIP_MEMORY_SCOPE_AGENT
using pg8::pkbf; using pg8::silu_f;
__device__ __forceinline__ float bf2f(unsigned short b) { return __uint_as_float((unsigned)b << 16); }
__device__ __forceinline__ float bflo(unsigned w) { return __uint_as_float(w << 16); }
__device__ __forceinline__ float bfhi(unsigned w) { return __uint_as_float(w & 0xffff0000u); }

#define XB_TMO      128
#define XB_XCNT(j)  (256  + 64 * (j))
#define XB_XSUB(j)  (1280 + 64 * (j))
#define XB_XGEN(j)  (2304 + 64 * (j))
#define XB_TOP      3328
#define XB_TOPGEN   3392
#define XCD_BAR_WORDS 3456
#define XB_SPIN_CAP (1u << 22)
__device__ __forceinline__ unsigned xb_ld(unsigned* p)              { return __hip_atomic_load(p, __ATOMIC_RELAXED, __HIP_MEMORY_SCOPE_AGENT); }
__device__ __forceinline__ unsigned xb_add(unsigned* p, unsigned v) { return __hip_atomic_fetch_add(p, v, __ATOMIC_RELAXED, __HIP_MEMORY_SCOPE_AGENT); }
__device__ __forceinline__ unsigned xb_xcc_id() { return (unsigned)__builtin_amdgcn_s_getreg((3 << 11) | 20) & 0xFu; }
#define XB_SPIN(cond, bar) do { unsigned _sp = 0; while (cond) { __builtin_amdgcn_s_sleep(1); \
    if ((++_sp & 255u) == 0u) { if (xb_ld(&(bar)[XB_TMO])) break; if (_sp > XB_SPIN_CAP) { atomicAdd(&(bar)[XB_TMO], 1u); break; } } } } while (0)
struct XcdBarrier { unsigned* bar; unsigned x; volatile LAS unsigned* st; };
__device__ __forceinline__ XcdBarrier xcd_barrier_post(unsigned* bar, volatile LAS unsigned* st) {
    XcdBarrier b; b.bar = bar; b.x = xb_xcc_id(); b.st = st;
    if (threadIdx.x == 0) (void)xb_add(&bar[XB_XCNT(b.x)], 1u);
    return b;
}
__device__ __forceinline__ void xcd_barrier_complete(unsigned* bar, unsigned x, unsigned& nloc, unsigned& nx) {
    const unsigned G = gridDim.x * gridDim.y * gridDim.z;
    unsigned sum, cnt, mine, sp = 0u;
    for (;;) {
        sum = 0u; cnt = 0u; mine = 0u;
#pragma unroll
        for (unsigned j = 0; j < 16; ++j) { const unsigned c = xb_ld(&bar[XB_XCNT(j)]); sum += c; cnt += (c > 0u) ? 1u : 0u; mine = (j == x) ? c : mine; }
        if (sum == G) break;
        __builtin_amdgcn_s_sleep(1);
        if ((++sp & 255u) == 0u) { if (xb_ld(&bar[XB_TMO])) break; if (sp > XB_SPIN_CAP) { atomicAdd(&bar[XB_TMO], 1u); break; } }
    }
    nloc = mine > 0u ? mine : 1u; nx = cnt > 0u ? cnt : 1u;
}
__device__ __forceinline__ void xcd_barrier(const XcdBarrier& b) {
    asm volatile("s_waitcnt vmcnt(0)" ::: "memory");
    __syncthreads();
    if (threadIdx.x == 0) {
        unsigned* bar = b.bar;
        __builtin_amdgcn_s_waitcnt(0);
        unsigned nloc = b.st[0], nx = b.st[1];
        if (nloc == 0u) { xcd_barrier_complete(bar, b.x, nloc, nx); b.st[0] = nloc; b.st[1] = nx; }
        const unsigned old = xb_add(&bar[XB_XSUB(b.x)], 1u);
        const unsigned gen = old / nloc;
        if (old + 1u == (gen + 1u) * nloc) {
            __builtin_amdgcn_fence(__ATOMIC_RELEASE, "agent");
            asm volatile("s_waitcnt vmcnt(0)" ::: "memory");
            const unsigned og = xb_add(&bar[XB_TOP], 1u);
            const unsigned tg = og / nx;
            if (og + 1u == (tg + 1u) * nx) xb_add(&bar[XB_TOPGEN], 1u);
            else XB_SPIN(xb_ld(&bar[XB_TOPGEN]) == tg, bar);
            __builtin_amdgcn_fence(__ATOMIC_ACQUIRE, "agent");
            xb_add(&bar[XB_XGEN(b.x)], 1u);
            asm volatile("s_waitcnt vmcnt(0)" ::: "memory");
        } else {
            XB_SPIN(xb_ld(&bar[XB_XGEN(b.x)]) == gen, bar);
            __builtin_amdgcn_fence(__ATOMIC_ACQUIRE, "agent");
            asm volatile("s_waitcnt vmcnt(0)" ::: "memory");
        }
    }
    __syncthreads();
}

#define LDS_WAIT() asm volatile("s_waitcnt lgkmcnt(0)" ::: "memory")
__device__ __forceinline__ float wave_sum(float v) {
#pragma unroll
    for (int o = 1; o < 64; o <<= 1) v += __shfl_xor(v, o);
    return v;
}

__device__ __forceinline__ float wave_max_f(float x) {
    int v = (int)__float_as_uint(x);
#define WMX_STEP(ctrl, rmask) { const int o = __builtin_amdgcn_update_dpp(v, v, ctrl, rmask, 0xf, false); v = (int)__float_as_uint(fmaxf(__uint_as_float((unsigned)v), __uint_as_float((unsigned)o))); }
    WMX_STEP(0xb1, 0xf)
    WMX_STEP(0x4e, 0xf)
    WMX_STEP(0x114, 0xf)
    WMX_STEP(0x118, 0xf)
    WMX_STEP(0x142, 0xa)
    WMX_STEP(0x143, 0xc)
#undef WMX_STEP
    return __uint_as_float((unsigned)__builtin_amdgcn_readlane(v, 63));
}
__device__ __forceinline__ float wave_sum_dpp(float x) {
    int v = (int)__float_as_uint(x);
#define WSM_STEP(ctrl, rmask) { const int o = __builtin_amdgcn_update_dpp(0, v, ctrl, rmask, 0xf, false); v = (int)__float_as_uint(__uint_as_float((unsigned)v) + __uint_as_float((unsigned)o)); }
    WSM_STEP(0xb1, 0xf)
    WSM_STEP(0x4e, 0xf)
    WSM_STEP(0x114, 0xf)
    WSM_STEP(0x118, 0xf)
    WSM_STEP(0x142, 0xa)
    WSM_STEP(0x143, 0xc)
#undef WSM_STEP
    return __uint_as_float((unsigned)__builtin_amdgcn_readlane(v, 63));
}
__device__ __forceinline__ float dpp16_sum(float x) {
    int v = (int)__float_as_uint(x);
#define D8_STEP(ctrl) { const int o = __builtin_amdgcn_update_dpp(v, v, ctrl, 0xf, 0xf, false); v = (int)__float_as_uint(__uint_as_float((unsigned)v) + __uint_as_float((unsigned)o)); }
    D8_STEP(0xb1) D8_STEP(0x4e) D8_STEP(0x141) D8_STEP(0x140)
#undef D8_STEP
    return __uint_as_float((unsigned)v);
}
struct Args { const float* in[22]; float* out; unsigned char* ws; int ph_lo, ph_hi, aux, pad; };
__device__ __forceinline__ const float* inp(int i) {
    typedef const float* cfp;
    const __attribute__((address_space(4))) cfp* ka = (const __attribute__((address_space(4))) cfp*)__builtin_amdgcn_kernarg_segment_ptr();
    return *(const volatile __attribute__((address_space(4))) cfp*)(ka + i);
}

__device__ __forceinline__ void transpose_tile_p(const float* src, int ldsrc, bf16* dst, int ldd, const int (&ro)[4], LAS float* scr, int lane) {
    float tv[32];
#pragma unroll
    for (int i = 0; i < 32; ++i) tv[i] = __builtin_nontemporal_load(src + (size_t)(2 * i + (lane >> 5)) * ldsrc + (lane & 31));
#pragma unroll
    for (int i = 0; i < 32; ++i) scr[(2 * i + (lane >> 5)) * 33 + (lane & 31)] = tv[i];
    LDS_WAIT(); asm volatile("" ::: "memory");
    const int c = lane & 7;
#pragma unroll
    for (int j = 0; j < 4; ++j) { const int n = (lane >> 3) + 8 * j; const LAS float* s = scr + (8 * c) * 33 + n;
        v4u o; o.x = pkbf(s[0 * 33], s[1 * 33]); o.y = pkbf(s[2 * 33], s[3 * 33]); o.z = pkbf(s[4 * 33], s[5 * 33]); o.w = pkbf(s[6 * 33], s[7 * 33]);
        *(GAS v4u*)(dst + (size_t)(ro[j] + (lane >> 3)) * ldd + 8 * c) = o; }
    LDS_WAIT(); asm volatile("" ::: "memory");
}
__device__ __forceinline__ void transpose_tile(const float* src, int ldsrc, bf16* dst, int ldd, LAS float* scr, int lane) {
    float tv[32];
#pragma unroll
    for (int i = 0; i < 32; ++i) tv[i] = __builtin_nontemporal_load(src + (size_t)(2 * i + (lane >> 5)) * ldsrc + (lane & 31));
#pragma unroll
    for (int i = 0; i < 32; ++i) scr[(2 * i + (lane >> 5)) * 33 + (lane & 31)] = tv[i];
    LDS_WAIT(); asm volatile("" ::: "memory");
    const int c = lane & 7;
#pragma unroll
    for (int j = 0; j < 4; ++j) { const int n = (lane >> 3) + 8 * j; const LAS float* s = scr + (8 * c) * 33 + n;
        v4u o; o.x = pkbf(s[0 * 33], s[1 * 33]); o.y = pkbf(s[2 * 33], s[3 * 33]); o.z = pkbf(s[4 * 33], s[5 * 33]); o.w = pkbf(s[6 * 33], s[7 * 33]);
        *(GAS v4u*)(dst + (size_t)n * ldd + 8 * c) = o; }
    LDS_WAIT(); asm volatile("" ::: "memory");
}
__device__ __forceinline__ void p0_phase(const Args& a, LAS unsigned char* lds, int tid, int lane, int wave, int G) {
    unsigned char* ws = a.ws;
    if ((int)blockIdx.x < 192) {
        LAS float* sc = (LAS float*)lds;
        LAS float* red = (LAS float*)(lds + 32768);
        const float* c = inp(1);
        for (int i = tid; i < 8192; i += NTHR) sc[i] = silu_f(c[i]);
        __syncthreads();
        const int cl = tid & 31, ks = tid >> 5, col = blockIdx.x * 32 + cl;
        const float* w = inp(2) + (size_t)(ks * 64) * 6144 + col;
        float acc[8];
#pragma unroll
        for (int b = 0; b < 8; ++b) acc[b] = 0.f;
#pragma unroll 8
        for (int k = 0; k < 64; ++k) { const float wv = w[(size_t)k * 6144];
#pragma unroll
            for (int b = 0; b < 8; ++b) acc[b] += sc[b * 1024 + ks * 64 + k] * wv; }
#pragma unroll
        for (int b = 0; b < 8; ++b) red[(ks * 8 + b) * 32 + cl] = acc[b];
        __syncthreads();
        if (tid < 256) { const int b = tid >> 5; float s = 0.f;
#pragma unroll
            for (int k2 = 0; k2 < 16; ++k2) s += red[(k2 * 8 + b) * 32 + cl];
            ((float*)(ws + WS_MOD))[b * 6144 + col] = s + inp(3)[col]; }
        __syncthreads();
    }
    {
        LAS float* blk = (LAS float*)lds;
        LAS float* pm = (LAS float*)(lds + LX_TEXP);
        LAS float* inv = (LAS float*)(lds + LX_CNT);
        const int n = tid & 31, ks = tid >> 5;
        float tv[64];
        int it = blockIdx.x;
        constexpr int NB1 = (NE + 1) * 16 + INC / 32;
#define B1_DESC(item, SRC, LD, DST, SCL) do { if ((item) < (NE + 1) * 16) { const int e_ = (item) >> 4, up_ = ((item) >> 3) & 1, n0_ = 32 * ((item) & 7); const int dr_ = 256 * (n0_ >> 7) + 128 * up_ + (n0_ & 127); \
                LD = 256; if (e_ < NE) { SRC = inp(15 + up_) + (size_t)e_ * 1024 * 256 + n0_; DST = ws + WS_WGU + (size_t)(e_ * 512 + dr_) * 1024; SCL = (float*)(ws + WS_SWGU) + e_ * 512 + dr_; } \
                else { SRC = inp(18 + up_) + n0_; DST = ws + WS_WGU + (size_t)(NE * 512 + dr_) * 1024; SCL = (float*)(ws + WS_SWGU) + NE * 512 + dr_; } } \
            else { const int n0_ = 32 * ((item) - (NE + 1) * 16); LD = INC; SRC = inp(4) + n0_; DST = ws + WS_WINQ + (size_t)n0_ * 1024; SCL = (float*)(ws + WS_SWIN) + n0_; } } while (0)
#define B1_LOAD(item) do { const float* s0_; int ld_; unsigned char* d0_; float* c0_; B1_DESC(item, s0_, ld_, d0_, c0_); (void)d0_; (void)c0_; const float* sp_ = s0_ + (size_t)(ks * 64) * ld_ + n; \
            _Pragma("unroll") for (int k = 0; k < 64; ++k) tv[k] = __builtin_nontemporal_load(sp_ + (size_t)k * ld_); } while (0)
        if (it < NB1) B1_LOAD(it);
        for (; it < NB1; it += G) {
            const float* src0; int ld0; unsigned char* dst0; float* scl0; B1_DESC(it, src0, ld0, dst0, scl0); (void)src0; (void)ld0;
            float mxv = 0.f;
#pragma unroll
            for (int k = 0; k < 64; ++k) { mxv = fmaxf(mxv, fabsf(tv[k])); blk[(ks * 64 + k) * 32 + n] = tv[k]; }
            pm[ks * 32 + n] = mxv;
            __syncthreads();
            if (it + G < NB1) B1_LOAD(it + G);
            if (tid < 32) { float mx2 = 0.f;
#pragma unroll
                for (int k2 = 0; k2 < 16; ++k2) mx2 = fmaxf(mx2, pm[k2 * 32 + tid]);
                const float sc = mx2 > 0.f ? mx2 * (1.0f / 127.0f) : 1.0f; inv[tid] = 1.0f / sc; scl0[tid] = sc; }
            __syncthreads();
            const float iv = inv[n];
#pragma unroll
            for (int c2 = 0; c2 < 2; ++c2) { const int kc = ks + 16 * c2; const LAS float* s = blk + (32 * kc) * 32 + n;
                unsigned q[8];
#pragma unroll
                for (int w4 = 0; w4 < 8; ++w4) { unsigned pk = 0u;
#pragma unroll
                    for (int b = 0; b < 4; ++b) { int qi = (int)rintf(s[(4 * w4 + b) * 32] * iv); qi = qi > 127 ? 127 : (qi < -127 ? -127 : qi); pk |= ((unsigned)qi & 0xffu) << (8 * b); }
                    q[w4] = pk; }
                unsigned char* dp = dst0 + (size_t)n * 1024 + 32 * kc;
                *(GAS v4u*)dp = (v4u){q[0], q[1], q[2], q[3]}; *(GAS v4u*)(dp + 16) = (v4u){q[4], q[5], q[6], q[7]}; }
            __syncthreads();
        }
#undef B1_LOAD
#undef B1_DESC
        LAS float* pm2 = pm;
        LAS float* inv2 = (LAS float*)(lds + LX_GL);
        const int n2 = tid & 127, ks2 = tid >> 7;
        it = blockIdx.x;
#define B2_LOAD(item) do { const int e_ = (item) >> 3, n0_ = 128 * ((item) & 7); const float* sp_ = (e_ < NE ? inp(17) + (size_t)e_ * 256 * 1024 : inp(20)) + (size_t)(ks2 * 64) * 1024 + n0_ + n2; \
            _Pragma("unroll") for (int k = 0; k < 64; ++k) tv[k] = __builtin_nontemporal_load(sp_ + (size_t)k * 1024); } while (0)
        if (it < NEX * 8) B2_LOAD(it);
        for (; it < NEX * 8; it += G) {
            const int e = it >> 3, n0 = 128 * (it & 7);
            const int cg = n0 + n2, c2 = cg & 255; const int drow = e * 1024 + (cg & ~255) + 128 * ((c2 >> 3) & 1) + 32 * (c2 >> 6) + 8 * ((c2 >> 4) & 3) + (c2 & 7);
            float mxv = 0.f;
#pragma unroll
            for (int k = 0; k < 64; ++k) { mxv = fmaxf(mxv, fabsf(tv[k])); blk[(ks2 * 64 + k) * 128 + n2] = tv[k]; }
            pm2[ks2 * 128 + n2] = mxv;
            __syncthreads();
            if (it + G < NEX * 8) B2_LOAD(it + G);
            if (tid < 64) { float mx2 = 0.f;
#pragma unroll
                for (int i8 = 0; i8 < 8; ++i8) mx2 = fmaxf(mx2, pm2[tid + 64 * i8]);
                mx2 = wave_max_f(mx2);
                const float sc = mx2 > 0.f ? mx2 * (1.0f / 127.0f) : 1.0f; if (tid == 0) { inv2[0] = 1.0f / sc; ((float*)(ws + WS_SWD))[it] = sc; } }
            __syncthreads();
            const float iv = inv2[0];
#pragma unroll
            for (int c3 = 0; c3 < 2; ++c3) { const int kc = ks2 + 4 * c3; const LAS float* s = blk + (32 * kc) * 128 + n2;
                unsigned q[8];
#pragma unroll
                for (int w4 = 0; w4 < 8; ++w4) { unsigned pk = 0u;
#pragma unroll
                    for (int b = 0; b < 4; ++b) { int qi = (int)rintf(s[(4 * w4 + b) * 128] * iv); qi = qi > 127 ? 127 : (qi < -127 ? -127 : qi); pk |= ((unsigned)qi & 0xffu) << (8 * b); }
                    q[w4] = pk; }
                unsigned char* dp = ws + WS_WD + (size_t)drow * 256 + 32 * kc;
                *(GAS v4u*)dp = (v4u){q[0], q[1], q[2], q[3]}; *(GAS v4u*)(dp + 16) = (v4u){q[4], q[5], q[6], q[7]}; }
            __syncthreads();
        }
#undef B2_LOAD
    }
    LAS float* scr = (LAS float*)(lds + wave * 16384);
    const int gw = blockIdx.x * NWAVES + wave, NGW = G * NWAVES;
    constexpr int I_IN = 16 * 56, I_OUT = 16 * 32, I_R = 16 * 8, I_SD = 4 * 32, I_E = 128;
    constexpr int NSMALL = I_OUT + I_R;
    constexpr int NITEMS = NSMALL;
    for (int it = gw; it < NITEMS; it += NGW) {
        int r = it;
        if (r < NSMALL) {
            if (r < I_OUT) { const int kb = r / 32, nb = r % 32; transpose_tile(inp(12) + (size_t)(64 * kb) * 1024 + 32 * nb, 1024, (bf16*)(ws + WS_WOUT) + (size_t)(32 * nb) * 1024 + 64 * kb, 1024, scr, lane); continue; } r -= I_OUT;
            if (r < I_R) { const int kb = r / 8, nb = r % 8; transpose_tile(inp(13) + (size_t)(64 * kb) * 256 + 32 * nb, 256, (bf16*)(ws + WS_WRS) + (size_t)(32 * nb) * 1024 + 64 * kb, 1024, scr, lane); continue; } r -= I_R;
        }
    }
}

__device__ __forceinline__ void norm_phase(const float* src, bf16* dst, const float* mod, int shoff, int lane, int wave, int G) {
    const int gw = blockIdx.x * NWAVES + wave, NGW = G * NWAVES;
    for (int m = gw; m < T; m += NGW) {
        const GAS f32x4* xr = (const GAS f32x4*)(src + (size_t)m * D) + lane;
        const float* mb = mod + (size_t)(m >> 12) * 6144 + shoff;
        f32x4 v[4]; float s = 0.f;
#pragma unroll
        for (int j = 0; j < 4; ++j) { v[j] = xr[64 * j]; s += (v[j].x * v[j].x + v[j].y * v[j].y) + (v[j].z * v[j].z + v[j].w * v[j].w); }
        const float r = 1.0f / sqrtf(wave_sum(s) * (1.f / D) + EPS);
        GAS v2u* o8 = (GAS v2u*)(dst + (size_t)m * D) + lane;
#pragma unroll
        for (int j = 0; j < 4; ++j) { const f32x4 sh = *(const f32x4*)(mb + 4 * lane + 256 * j), sc = *(const f32x4*)(mb + 1024 + 4 * lane + 256 * j);
            const f32x4 y = v[j] * r * (sc + 1.0f) + sh; v2u o; o.x = pkbf(y.x, y.y); o.y = pkbf(y.z, y.w); o8[64 * j] = o; }
    }
}

__device__ __forceinline__ void quant_phase(const bf16* src, unsigned char* dst, float* scales, int lane, int wave, int G) {
    const int gw = blockIdx.x * NWAVES + wave, NGW = G * NWAVES;
    for (int t = gw; t < T; t += NGW) {
        const GAS v4u* sp = (const GAS v4u*)(src + (size_t)t * D + 16 * lane);
        const v4u a0 = sp[0], a1 = sp[1];
        float v[16];
        v[0] = bflo(a0.x); v[1] = bfhi(a0.x); v[2] = bflo(a0.y); v[3] = bfhi(a0.y); v[4] = bflo(a0.z); v[5] = bfhi(a0.z); v[6] = bflo(a0.w); v[7] = bfhi(a0.w);
        v[8] = bflo(a1.x); v[9] = bfhi(a1.x); v[10] = bflo(a1.y); v[11] = bfhi(a1.y); v[12] = bflo(a1.z); v[13] = bfhi(a1.z); v[14] = bflo(a1.w); v[15] = bfhi(a1.w);
        float mxv = 0.f;
#pragma unroll
        for (int i = 0; i < 16; ++i) mxv = fmaxf(mxv, fabsf(v[i]));
        mxv = wave_max_f(mxv);
        const float sc = mxv > 0.f ? mxv * (1.0f / 127.0f) : 1.0f, iv = 1.0f / sc;
        unsigned q[4];
#pragma unroll
        for (int w4 = 0; w4 < 4; ++w4) { unsigned pk = 0u;
#pragma unroll
            for (int b = 0; b < 4; ++b) { int qi = (int)rintf(v[4 * w4 + b] * iv); qi = qi > 127 ? 127 : (qi < -127 ? -127 : qi); pk |= ((unsigned)qi & 0xffu) << (8 * b); }
            q[w4] = pk; }
        *(GAS v4u*)(dst + (size_t)t * D + 16 * lane) = (v4u){q[0], q[1], q[2], q[3]};
        if (lane == 0) scales[t] = sc;
    }
}

__device__ __forceinline__ void norm_quant_phase(const float* src, unsigned char* dst, float* scales, const float* mod, int lane, int wave, int G) {
    const int gw = blockIdx.x * NWAVES + wave, NGW = G * NWAVES;
    for (int m = gw; m < T; m += NGW) {
        const GAS f32x4* xr = (const GAS f32x4*)(src + (size_t)m * D + 16 * lane);
        const float* mb = mod + (size_t)(m >> 12) * 6144 + 16 * lane;
        f32x4 v[4]; float s = 0.f;
#pragma unroll
        for (int j = 0; j < 4; ++j) { v[j] = xr[j]; s += (v[j].x * v[j].x + v[j].y * v[j].y) + (v[j].z * v[j].z + v[j].w * v[j].w); }
        const float r = 1.0f / sqrtf(wave_sum_dpp(s) * (1.f / D) + EPS);
        float mxv = 0.f;
#pragma unroll
        for (int j = 0; j < 4; ++j) { const f32x4 sh = *(const f32x4*)(mb + 4 * j), sc = *(const f32x4*)(mb + 1024 + 4 * j);
            v[j] = v[j] * r * (sc + 1.0f) + sh; mxv = fmaxf(mxv, fmaxf(fmaxf(fabsf(v[j].x), fabsf(v[j].y)), fmaxf(fabsf(v[j].z), fabsf(v[j].w)))); }
        mxv = wave_max_f(mxv);
        const float qs = mxv > 0.f ? mxv * (1.0f / 127.0f) : 1.0f, iv = 1.0f / qs;
        unsigned q[4];
#pragma unroll
        for (int j = 0; j < 4; ++j) { unsigned pk = 0u;
#pragma unroll
            for (int b = 0; b < 4; ++b) { int qi = (int)rintf(v[j][b] * iv); qi = qi > 127 ? 127 : (qi < -127 ? -127 : qi); pk |= ((unsigned)qi & 0xffu) << (8 * b); }
            q[j] = pk; }
        *(GAS v4u*)(dst + (size_t)m * D + 16 * lane) = (v4u){q[0], q[1], q[2], q[3]};
        if (lane == 0) scales[m] = qs;
    }
}
__device__ __forceinline__ void quant_rows(const bf16* src, unsigned char* dst, float* scales, LAS float* rs, int row0, int lane, int wave) {
    for (int r = wave; r < 256; r += NWAVES) { const int t = row0 + r;
        const GAS v4u* sp = (const GAS v4u*)(src + (size_t)t * D + 16 * lane);
        const v4u a0 = sp[0], a1 = sp[1];
        float v[16];
        v[0] = bflo(a0.x); v[1] = bfhi(a0.x); v[2] = bflo(a0.y); v[3] = bfhi(a0.y); v[4] = bflo(a0.z); v[5] = bfhi(a0.z); v[6] = bflo(a0.w); v[7] = bfhi(a0.w);
        v[8] = bflo(a1.x); v[9] = bfhi(a1.x); v[10] = bflo(a1.y); v[11] = bfhi(a1.y); v[12] = bflo(a1.z); v[13] = bfhi(a1.z); v[14] = bflo(a1.w); v[15] = bfhi(a1.w);
        float mxv = 0.f;
#pragma unroll
        for (int i = 0; i < 16; ++i) mxv = fmaxf(mxv, fabsf(v[i]));
        mxv = wave_max_f(mxv);
        const float sc = mxv > 0.f ? mxv * (1.0f / 127.0f) : 1.0f, iv = 1.0f / sc;
        unsigned q[4];
#pragma unroll
        for (int w4 = 0; w4 < 4; ++w4) { unsigned pk = 0u;
#pragma unroll
            for (int b = 0; b < 4; ++b) { int qi = (int)rintf(v[4 * w4 + b] * iv); qi = qi > 127 ? 127 : (qi < -127 ? -127 : qi); pk |= ((unsigned)qi & 0xffu) << (8 * b); }
            q[w4] = pk; }
        *(GAS v4u*)(dst + (size_t)t * D + 16 * lane) = (v4u){q[0], q[1], q[2], q[3]};
        if (lane == 0) { scales[t] = sc; rs[r] = sc; }
    }
}

constexpr int VT_LD = 260;
constexpr int BD_LD = 192;
constexpr int AL_VT = 0, AL_BIAS = 2 * 64 * VT_LD * 2  , AL_SS = AL_BIAS + 8 * BD_LD * 4, AL_GAIN = AL_SS + 2 * 8 * 32 * 4, AL_END = AL_GAIN + 512 * 4;
constexpr int CL_U = 0, CL_C = 31 * 512 * 4  ;
static_assert(AL_END <= RING_BYTES && 2 * CL_C + 4096 <= RING_BYTES, "P3 LDS");
#define MFMA32(a, b, c) __builtin_amdgcn_mfma_f32_32x32x16_bf16((a), (b), (c), 0, 0, 0)
#define LDS_BAR() do { asm volatile("s_waitcnt lgkmcnt(0)" ::: "memory"); __builtin_amdgcn_s_barrier(); asm volatile("" ::: "memory"); } while (0)
__device__ __forceinline__ void p3_unit(const Args& a, LAS unsigned char* lds, int unit, int tid, int lane, int wave) {
    unsigned char* ws = a.ws;
    const bf16* proj = (const bf16*)(ws + WS_PROJ);
    bf16* cat = (bf16*)(ws + WS_CAT);
    const int b = unit >> 5, qb = unit & 31, t0 = b * SEQ + qb * 128;
#ifndef REP_ATT
#define REP_ATT 1
#endif
#ifndef REP_CONV
#define REP_CONV 1
#endif
#pragma nounroll
    for (int ra_ = 0; ra_ < REP_ATT; ++ra_)
    {
        LAS bf16* vt = (LAS bf16*)(lds + AL_VT);
        LAS float* biasd = (LAS float*)(lds + AL_BIAS);
        LAS float* ssb = (LAS float*)(lds + AL_SS);
#pragma unroll
        for (int i = 0; i < 4; ++i) { const int p = tid + NTHR * i, kp = p & 127, c16 = p >> 7, ki = 2 * kp; const int tk = (qb == 0 && ki < 128) ? t0 + ki : t0 - 128 + ki;
            const v4u v0 = *(const GAS v4u*)(proj + (size_t)tk * INC + 640 + 8 * c16), v1 = *(const GAS v4u*)(proj + (size_t)(tk + 1) * INC + 640 + 8 * c16);
            LAS unsigned* d = (LAS unsigned*)(vt + (size_t)(8 * c16) * VT_LD + ki);
            d[0 * (VT_LD / 2)] = (v0.x & 0xffffu) | (v1.x << 16); d[1 * (VT_LD / 2)] = (v0.x >> 16) | (v1.x & 0xffff0000u);
            d[2 * (VT_LD / 2)] = (v0.y & 0xffffu) | (v1.y << 16); d[3 * (VT_LD / 2)] = (v0.y >> 16) | (v1.y & 0xffff0000u);
            d[4 * (VT_LD / 2)] = (v0.z & 0xffffu) | (v1.z << 16); d[5 * (VT_LD / 2)] = (v0.z >> 16) | (v1.z & 0xffff0000u);
            d[6 * (VT_LD / 2)] = (v0.w & 0xffffu) | (v1.w << 16); d[7 * (VT_LD / 2)] = (v0.w >> 16) | (v1.w & 0xffff0000u); }
        for (int i = tid; i < 8 * BD_LD; i += NTHR) { const int hh = i / BD_LD, n = i % BD_LD - 32; float bv = 0.f;
            if (n >= 0 && n < 128) { int bk = n; if (n >= 16) { bk = 16 + (int)(log2f((float)n * (1.0f / 16.0f)) * (16.0f / 3.0f)); bk = bk > 31 ? 31 : bk; }
                bv = inp(6)[bk * 8 + hh] * 1.44269504f; }
            biasd[i] = bv; }
        LAS float* gain = (LAS float*)(lds + AL_GAIN);
        gain[tid] = inp(7)[tid];
        __syncthreads();
        const int h = wave, kvh = h >> 2, hh = lane >> 5;
        const float sink2 = inp(5)[h] * 1.44269504f;
        for (int i = 0; i < 4; ++i) {
            int r = lane & 31; asm volatile("" : "+v"(r));
            const int tq = t0 + 32 * i + r;
            bf16x8 qf[4];
#pragma unroll
            for (int s = 0; s < 4; ++s) qf[s] = *(const GAS bf16x8*)(proj + (size_t)tq * INC + h * 64 + 16 * s + 8 * hh);
            f32x16 sc[5];
#pragma unroll
            for (int kb = 0; kb < 5; ++kb) {
                const int ki = 32 * (i + kb) + r; const int tk = (qb == 0 && ki < 128) ? t0 + (ki & 127) : t0 - 128 + ki;
                bf16x8 kf[4];
#pragma unroll
                for (int s = 0; s < 4; ++s) kf[s] = *(const GAS bf16x8*)(proj + (size_t)tk * INC + 512 + kvh * 64 + 16 * s + 8 * hh);
                f32x16 acc;
#pragma unroll
                for (int e = 0; e < 16; ++e) acc[e] = 0.f;
#pragma unroll
                for (int s = 0; s < 4; ++s) acc = MFMA32(kf[s], qf[s], acc);
                sc[kb] = acc;
            }
            const LAS float* bdr = biasd + h * BD_LD + 32 + 128 + r - 4 * hh;
            float mx = sink2;
#pragma unroll
            for (int kb = 0; kb < 5; ++kb) {
                const bool tile_ok = qb > 0 || (i + kb) >= 4;
#pragma unroll
                for (int e = 0; e < 16; ++e) { const int kk0 = (e & 3) + 8 * (e >> 2); const int kk = kk0 + 4 * hh;
                    bool ok = tile_ok; if (kb == 0) ok = ok && (kk > r); if (kb == 4) ok = ok && (kk <= r);
                    const float bv = bdr[-32 * kb - kk0];
                    const float lv = sc[kb][e] * (0.125f * 1.44269504f) + bv; const float lg = ok ? lv : -INFINITY; sc[kb][e] = lg; mx = fmaxf(mx, lg); } }
            mx = fmaxf(mx, __shfl_xor(mx, 32));
            float sum = 0.f;
#pragma unroll
            for (int kb = 0; kb < 5; ++kb)
#pragma unroll
                for (int e = 0; e < 16; ++e) { const float p = __builtin_amdgcn_exp2f(sc[kb][e] - mx); sc[kb][e] = p; sum += p; }
            sum += __shfl_xor(sum, 32);
            const float inv = 1.0f / (sum + __builtin_amdgcn_exp2f(sink2 - mx));
            f32x16 o0, o1;
#pragma unroll
            for (int e = 0; e < 16; ++e) { o0[e] = 0.f; o1[e] = 0.f; }
#pragma unroll
            for (int kb = 0; kb < 5; ++kb)
#pragma unroll
                for (int s = 0; s < 2; ++s) {
                    v4u pw; pw.x = pkbf(sc[kb][8 * s + 0], sc[kb][8 * s + 1]); pw.y = pkbf(sc[kb][8 * s + 2], sc[kb][8 * s + 3]); pw.z = pkbf(sc[kb][8 * s + 4], sc[kb][8 * s + 5]); pw.w = pkbf(sc[kb][8 * s + 6], sc[kb][8 * s + 7]);
                    const bf16x8 pf = __builtin_bit_cast(bf16x8, pw);
                    const int kcol = 32 * (i + kb) + 16 * s + 4 * hh;
                    const LAS bf16* v0 = vt + (size_t)(kvh * 64 + r) * VT_LD + kcol;
                    const s16x4 a0 = *(const LAS s16x4*)v0, a1 = *(const LAS s16x4*)(v0 + 8);
                    const s16x4 c0 = *(const LAS s16x4*)(v0 + 32 * VT_LD), c1 = *(const LAS s16x4*)(v0 + 32 * VT_LD + 8);
                    o0 = MFMA32(__builtin_shufflevector(a0, a1, 0, 1, 2, 3, 4, 5, 6, 7), pf, o0);
                    o1 = MFMA32(__builtin_shufflevector(c0, c1, 0, 1, 2, 3, 4, 5, 6, 7), pf, o1);
                }
            float ss = 0.f;
#pragma unroll
            for (int e = 0; e < 16; ++e) { o0[e] *= inv; o1[e] *= inv; ss += o0[e] * o0[e] + o1[e] * o1[e]; }
            ss += __shfl_xor(ss, 32);
            LAS float* sb = ssb + (i & 1) * 256;
            if (hh == 0) sb[h * 32 + r] = ss;
            LDS_BAR();
            float tot = 0.f;
#pragma unroll
            for (int w = 0; w < 8; ++w) tot += sb[w * 32 + r];
            const float rn = 1.0f / sqrtf(tot * (1.0f / 512.0f) + EPS);
            bf16* orow = cat + (size_t)tq * D + h * 64 + 4 * hh;
            const LAS float* gp = gain + h * 64 + 4 * hh;
#pragma unroll
            for (int g = 0; g < 4; ++g) {
                const f32x4 g0 = *(const LAS f32x4*)(gp + 8 * g), g1 = *(const LAS f32x4*)(gp + 32 + 8 * g);
                v2u w0, w1;
                w0.x = pkbf(o0[4 * g + 0] * rn * g0.x, o0[4 * g + 1] * rn * g0.y); w0.y = pkbf(o0[4 * g + 2] * rn * g0.z, o0[4 * g + 3] * rn * g0.w);
                w1.x = pkbf(o1[4 * g + 0] * rn * g1.x, o1[4 * g + 1] * rn * g1.y); w1.y = pkbf(o1[4 * g + 2] * rn * g1.z, o1[4 * g + 3] * rn * g1.w);
                *(GAS v2u*)(orow + 8 * g) = w0; *(GAS v2u*)(orow + 32 + 8 * g) = w1;
            }
        }
        __syncthreads();
    }
#pragma nounroll
    for (int rc_ = 0; rc_ < REP_CONV; ++rc_)
    {
        LAS float* ub = (LAS float*)(lds + CL_U);
        LAS float* cb = (LAS float*)(lds + CL_C);
        __builtin_amdgcn_sched_barrier(0);
        int c = tid, ln8 = 8 * lane; asm volatile("" : "+v"(c), "+v"(ln8));
        float w[CW], acc[CW];
#pragma unroll
        for (int j = 0; j < CW; ++j) { w[j] = inp(8)[j * CC + c]; acc[j] = 0.f; }
        const float cbias = inp(9)[c];
        LAS float* lnp = (LAS float*)(lds + 2 * CL_C);
        lnp[c] = inp(10)[c]; lnp[512 + c] = inp(11)[c];
        v4u av[4], gv[4];
#define CONV_LOAD(grp_) do { const int tb_ = -30 + 31 * (grp_); _Pragma("unroll") for (int i4 = 0; i4 < 4; ++i4) { const int it = c + NTHR * i4, s = it >> 6, ch = (it & 63) * 8, tr = tb_ + s; \
            const bool okl = (it < 31 * 64) && tr < 128 && (qb > 0 || tr >= 0); const bf16* pr = proj + (size_t)(t0 + (okl ? tr : 0)) * INC; \
            av[i4] = *(const GAS v4u*)(pr + 768 + ch); gv[i4] = okl ? *(const GAS v4u*)(pr + 1280 + ch) : (v4u){0xff80ff80u, 0xff80ff80u, 0xff80ff80u, 0xff80ff80u}; } } while (0)
        CONV_LOAD(0);
        for (int grp = 0; grp < 6; ++grp) {
            const int tb = -30 + 31 * grp;
#pragma unroll
            for (int i4 = 0; i4 < 4; ++i4) { const int it = c + NTHR * i4, s = it >> 6, ch = (it & 63) * 8;
                if (it < 31 * 64) {
                    f32x4 u0, u1; const v4u a4 = av[i4], g4 = gv[i4];
                    u0.x = bflo(a4.x) * __builtin_amdgcn_rcpf(1.f + __expf(-bflo(g4.x))); u0.y = bfhi(a4.x) * __builtin_amdgcn_rcpf(1.f + __expf(-bfhi(g4.x)));
                    u0.z = bflo(a4.y) * __builtin_amdgcn_rcpf(1.f + __expf(-bflo(g4.y))); u0.w = bfhi(a4.y) * __builtin_amdgcn_rcpf(1.f + __expf(-bfhi(g4.y)));
                    u1.x = bflo(a4.z) * __builtin_amdgcn_rcpf(1.f + __expf(-bflo(g4.z))); u1.y = bfhi(a4.z) * __builtin_amdgcn_rcpf(1.f + __expf(-bfhi(g4.z)));
                    u1.z = bflo(a4.w) * __builtin_amdgcn_rcpf(1.f + __expf(-bflo(g4.w))); u1.w = bfhi(a4.w) * __builtin_amdgcn_rcpf(1.f + __expf(-bfhi(g4.w)));
                    *(LAS f32x4*)(ub + s * 512 + ch) = u0; *(LAS f32x4*)(ub + s * 512 + ch + 4) = u1; } }
            if (grp < 5) CONV_LOAD(grp + 1);
            LDS_BAR();
#pragma unroll
            for (int s = 0; s < CW; ++s) {
                const float u = ub[s * 512 + c];
#pragma unroll
                for (int j = 0; j < CW; ++j) acc[(s + 30 - j) % CW] += w[j] * u;
                cb[s * 512 + c] = acc[s] + cbias; acc[s] = 0.f;
            }
            LDS_BAR();
#pragma nounroll
            for (int itn = 0; itn < 2; ++itn) { const int s = 2 * wave + (lane >> 5) + 16 * itn; const int tr = tb + s; const bool okt = s < CW && tr >= 0 && tr < 128;
                const LAS float* cp = cb + (okt ? s : 0) * 512 + 16 * (lane & 31);
                f32x4 xq[4]; float sm = 0.f;
#pragma unroll
                for (int q4 = 0; q4 < 4; ++q4) { xq[q4] = *(const LAS f32x4*)(cp + 4 * q4); sm += (xq[q4].x + xq[q4].y) + (xq[q4].z + xq[q4].w); }
                sm = dpp16_sum(sm); sm += __shfl_xor(sm, 16);
                const float mu = sm * (1.f / 512.f); float sq = 0.f;
#pragma unroll
                for (int q4 = 0; q4 < 4; ++q4) { xq[q4] = xq[q4] - mu; sq += (xq[q4].x * xq[q4].x + xq[q4].y * xq[q4].y) + (xq[q4].z * xq[q4].z + xq[q4].w * xq[q4].w); }
                sq = dpp16_sum(sq); sq += __shfl_xor(sq, 16);
                const float rs = 1.0f / sqrtf(sq * (1.f / 512.f) + EPS);
                v4u o0, o1;
                { const LAS float* gq = lnp + 16 * (lane & 31); const f32x4 y0 = xq[0] * rs * *(const LAS f32x4*)gq + *(const LAS f32x4*)(gq + 512), y1 = xq[1] * rs * *(const LAS f32x4*)(gq + 4) + *(const LAS f32x4*)(gq + 516); o0.x = pkbf(silu_f(y0.x), silu_f(y0.y)); o0.y = pkbf(silu_f(y0.z), silu_f(y0.w)); o0.z = pkbf(silu_f(y1.x), silu_f(y1.y)); o0.w = pkbf(silu_f(y1.z), silu_f(y1.w)); }
                { const LAS float* gq = lnp + 16 * (lane & 31) + 8; const f32x4 y0 = xq[2] * rs * *(const LAS f32x4*)gq + *(const LAS f32x4*)(gq + 512), y1 = xq[3] * rs * *(const LAS f32x4*)(gq + 4) + *(const LAS f32x4*)(gq + 516); o1.x = pkbf(silu_f(y0.x), silu_f(y0.y)); o1.y = pkbf(silu_f(y0.z), silu_f(y0.w)); o1.z = pkbf(silu_f(y1.x), silu_f(y1.y)); o1.w = pkbf(silu_f(y1.z), silu_f(y1.w)); }
                if (okt) { GAS v4u* op = (GAS v4u*)(cat + (size_t)(t0 + tr) * D + 512 + 16 * (lane & 31)); op[0] = o0; op[1] = o1; }
            }
        }
#undef CONV_LOAD
        __syncthreads();
    }
}

constexpr int CSTRIDE = 64;
__device__ __forceinline__ float dpp8_max(float x) {
    int v = (int)__float_as_uint(x);
#define D8_STEP(ctrl) { const int o = __builtin_amdgcn_update_dpp(v, v, ctrl, 0xf, 0xf, false); v = (int)__float_as_uint(fmaxf(__uint_as_float((unsigned)v), __uint_as_float((unsigned)o))); }
    D8_STEP(0xb1) D8_STEP(0x4e) D8_STEP(0x141)
#undef D8_STEP
    return __uint_as_float((unsigned)v);
}
__device__ __forceinline__ float dpp16_max(float x) {
    int v = (int)__float_as_uint(x);
#define D8_STEP(ctrl) { const int o = __builtin_amdgcn_update_dpp(v, v, ctrl, 0xf, 0xf, false); v = (int)__float_as_uint(fmaxf(__uint_as_float((unsigned)v), __uint_as_float((unsigned)o))); }
    D8_STEP(0xb1) D8_STEP(0x4e) D8_STEP(0x141) D8_STEP(0x140)
#undef D8_STEP
    return __uint_as_float((unsigned)v);
}
__device__ __forceinline__ float dpp8_sum(float x) {
    int v = (int)__float_as_uint(x);
#define D8_STEP(ctrl) { const int o = __builtin_amdgcn_update_dpp(v, v, ctrl, 0xf, 0xf, false); v = (int)__float_as_uint(__uint_as_float((unsigned)v) + __uint_as_float((unsigned)o)); }
    D8_STEP(0xb1) D8_STEP(0x4e) D8_STEP(0x141)
#undef D8_STEP
    return __uint_as_float((unsigned)v);
}
__device__ __forceinline__ void p7_phase(const Args& a, LAS unsigned char* lds, int tid, int lane, int wave, int G) {
    unsigned char* ws = a.ws;
    const float* logits = (const float*)(ws + WS_LOGITS);
    int* counts = (int*)(ws + WS_CTL) + CW_COUNTS;
    LAS int* hist = (LAS int*)lds;
    LAS int* cbase = (LAS int*)(lds + 1024);
    LAS float* rbias = (LAS float*)(lds + 2048);
    int* eidx_g = (int*)(ws + WS_EIDX); float* gw_g = (float*)(ws + WS_GW); int* pos_g = (int*)(ws + WS_POS);
    const int g = lane & 7, gb = lane & ~7;
    for (int ch = blockIdx.x; ch < T / 128; ch += G) {
        if (tid < NE) { hist[tid] = 0; rbias[tid] = inp(14)[tid]; }
        __syncthreads();
#pragma nounroll
        for (int ps = 0; ps < 2; ++ps) {
            const int t = ch * 128 + ps * 64 + (tid >> 3);
            float sel[32];
            const GAS f32x4* lp = (const GAS f32x4*)(logits + (size_t)t * NE + 32 * g);
#pragma unroll
            for (int i = 0; i < 8; ++i) { const f32x4 lg = lp[i]; const f32x4 rb = *(const LAS f32x4*)(rbias + 32 * g + 4 * i);
#pragma unroll
                for (int e = 0; e < 4; ++e) sel[4 * i + e] = 1.0f / (1.0f + __expf(-lg[e])) + rb[e]; }
            float m1 = -INFINITY, m2 = -INFINITY;
#pragma unroll
            for (int i = 0; i < 32; ++i) { const float v = sel[i]; m2 = fmaxf(m2, fminf(m1, v)); m1 = fmaxf(m1, v); }
            const float gs = m1 + m2; int rank = 0;
#pragma unroll
            for (int j = 0; j < 8; ++j) { const float o = __shfl(gs, gb + j); rank += (o > gs || (o == gs && j < g)) ? 1 : 0; }
            const bool selected = rank < 4;
            float lv[8]; int li[8];
#pragma unroll
            for (int k = 0; k < 8; ++k) { lv[k] = -INFINITY; li[k] = 0; }
            if (selected) {
#pragma unroll
                for (int i = 0; i < 32; ++i) { float v = sel[i]; int id = 32 * g + i;
#pragma unroll
                    for (int k = 0; k < 8; ++k) { const bool sw = v > lv[k]; const float tv = sw ? lv[k] : v; const int ti = sw ? li[k] : id; lv[k] = sw ? v : lv[k]; li[k] = sw ? id : li[k]; v = tv; id = ti; } }
            }
            float mysel = 0.f; int mye = 0;
#pragma unroll
            for (int rd = 0; rd < TOPK; ++rd) {
                const float mx = dpp8_max(lv[0]);
                const unsigned long long bal = __ballot(lv[0] == mx);
                const int wl = __builtin_ctz((unsigned)((bal >> gb) & 0xffull));
                const int widx = __shfl(li[0], gb + wl);
                if (g == wl) {
#pragma unroll
                    for (int k = 0; k < 7; ++k) { lv[k] = lv[k + 1]; li[k] = li[k + 1]; }
                    lv[7] = -INFINITY; }
                if (g == rd) { mysel = mx; mye = widx; }
            }
            const float mysc = mysel - rbias[mye];
            const float tot = dpp8_sum(mysc);
            const int rk = __hip_atomic_fetch_add(hist + mye, 1, __ATOMIC_RELAXED, __HIP_MEMORY_SCOPE_WORKGROUP);
            eidx_g[t * 8 + g] = mye; gw_g[t * 8 + g] = mysc / tot * 2.5f; pos_g[t * 8 + g] = rk;
        }
        __syncthreads();
        if (tid < NE) { const int c = hist[tid]; cbase[tid] = c > 0 ? atomicAdd(counts + CSTRIDE * tid, c) : 0; }
        __syncthreads();
        for (int i = tid; i < 1024; i += NTHR) { const int idx = ch * 1024 + i; const int e = __builtin_nontemporal_load(eidx_g + idx); const int p = __builtin_nontemporal_load(pos_g + idx) + cbase[e];
            pos_g[idx] = p; ((unsigned short*)(ws + WS_LIST))[(size_t)e * T + p] = (unsigned short)(idx >> 3); (ws + WS_SLOT)[(size_t)e * T + p] = (unsigned char)(idx & 7); }
        __syncthreads();
    }
}
__device__ __forceinline__ int build_tiles(const Args& a, LAS unsigned char* lds, int tid) {
    const int* counts = (const int*)(a.ws + WS_CTL) + CW_COUNTS;
    LAS int* base = (LAS int*)(lds + LX_BASE);
    LAS int* pb = (LAS int*)(lds + LX_GL);
    LAS unsigned short* texp = (LAS unsigned short*)(lds + LX_TEXP);
    if (tid < 64) {
        int c[4], p[4], pre = 0, ppre = 0;
#pragma unroll
        for (int i = 0; i < 4; ++i) { const int raw = __hip_atomic_load(counts + CSTRIDE * (4 * tid + i), RLX_AGENT); ((LAS int*)(lds + LX_CNT))[4 * tid + i] = raw; c[i] = (raw + 255) & ~255; pre += c[i];
            const int nt = c[i] >> 8, ch = (nt > 0 && raw - ((nt - 1) << 8) <= 128) ? 1 : 0; p[i] = ((nt - ch) << 16) | ch; ppre += p[i]; }
        int incl = pre, pincl = ppre;
#pragma unroll
        for (int o = 1; o < 64; o <<= 1) { const int x = __shfl_up(incl, o), y = __shfl_up(pincl, o); if (tid >= o) { incl += x; pincl += y; } }
        int run = incl - pre, prun = pincl - ppre;
#pragma unroll
        for (int i = 0; i < 4; ++i) { base[4 * tid + i] = run; run += c[i]; pb[4 * tid + i] = prun; prun += p[i]; }
        if (tid == 63) { base[NE] = run; base[NE + 1] = run + T; ((LAS int*)(lds + LX_CNT))[NE] = T; pb[NE] = prun; pb[NE + 1] = prun + ((T / 256) << 16); }
    }
    __syncthreads();
    if (tid < NEX) { const int t0 = base[tid] >> 8, t1 = base[tid + 1] >> 8; int fi = pb[tid] >> 16; const int ci = pb[tid] & 0xffff, ch = (pb[tid + 1] & 0xffff) - ci;
        for (int t = t0; t < t1; ++t) { texp[t] = (unsigned short)tid; if (ch && t == t1 - 1) ((LAS unsigned short*)(lds + LX_CT))[ci] = (unsigned short)t; else ((LAS unsigned short*)(lds + LX_FT))[fi++] = (unsigned short)t; } }
    __syncthreads();
    return pb[NEX];
}
__device__ __forceinline__ void p11_phase(const Args& a, LAS unsigned char* lds, int tid, int lane, int wave, int G) {
    unsigned char* ws = a.ws;
    const float* mod = (const float*)(ws + WS_MOD);
    const unsigned char* y = ws + WS_Y;
    const float* gwv = (const float*)(ws + WS_GW);
    const float* xin = a.out; float* out = a.aux ? (float*)(ws + WS_HID) : a.out;
    const float* fg = inp(21);
    typedef float f32x2 __attribute__((ext_vector_type(2)));
    const int gw = blockIdx.x * NWAVES + wave, NGW = G * NWAVES;
    for (int t = gw; t < T; t += NGW) {
        const float* g2 = mod + (size_t)(t >> 12) * 6144 + 5120 + 16 * lane;
        float myw = 0.f;
        if (lane < TOPK) myw = gwv[t * 8 + lane];
        const GAS v4u* yr = (const GAS v4u*)(y + (size_t)t * NSLOT * D + 16 * lane);
        v4u yv[NSLOT];
#pragma unroll
        for (int k = 0; k < NSLOT; ++k) yv[k] = yr[k * (D / 16)];
        f32x4 xv[4];
        { const GAS v4u* xp = (const GAS v4u*)((const bf16*)xin + (size_t)t * (2 * D) + 16 * lane); const v4u x0 = xp[0], x1v = xp[1];
            xv[0] = (f32x4){bflo(x0.x), bfhi(x0.x), bflo(x0.y), bfhi(x0.y)}; xv[1] = (f32x4){bflo(x0.z), bfhi(x0.z), bflo(x0.w), bfhi(x0.w)};
            xv[2] = (f32x4){bflo(x1v.x), bfhi(x1v.x), bflo(x1v.y), bfhi(x1v.y)}; xv[3] = (f32x4){bflo(x1v.z), bfhi(x1v.z), bflo(x1v.w), bfhi(x1v.w)}; }
        f32x4 m4[4];
#pragma unroll
        for (int j = 0; j < 4; ++j) m4[j] = (f32x4){0.f, 0.f, 0.f, 0.f};
#pragma unroll
        for (int k = 0; k < NSLOT; ++k) {
            const float wk = k < TOPK ? __uint_as_float((unsigned)__builtin_amdgcn_readlane((int)__float_as_uint(myw), k < TOPK ? k : 0)) : 1.0f;
#pragma unroll
            for (int j = 0; j < 4; ++j) { const f32x2 lo = __builtin_amdgcn_cvt_pk_f32_fp8((int)yv[k][j], false), hi = __builtin_amdgcn_cvt_pk_f32_fp8((int)yv[k][j], true);
                m4[j] += (f32x4){lo.x, lo.y, hi.x, hi.y} * wk; }
        }
        f32x4 v[4]; float s = 0.f;
#pragma unroll
        for (int j = 0; j < 4; ++j) { v[j] = xv[j] + *(const f32x4*)(g2 + 4 * j) * m4[j]; s += (v[j].x * v[j].x + v[j].y * v[j].y) + (v[j].z * v[j].z + v[j].w * v[j].w); }
        const float r = 1.0f / sqrtf(wave_sum_dpp(s) * (1.f / D) + EPS);
#pragma unroll
        for (int j = 0; j < 4; ++j) *(GAS f32x4*)(out + (size_t)t * D + 16 * lane + 4 * j) = v[j] * r * *(const f32x4*)(fg + 16 * lane + 4 * j);
    }
}

__global__ void __launch_bounds__(NTHR, 2) hyb_fwd(Args args) {
    extern __shared__ __attribute__((aligned(16))) unsigned char lds_raw[];
    LAS unsigned char* lds = (LAS unsigned char*)lds_raw;
    volatile LAS unsigned* MISC = (volatile LAS unsigned*)(lds + LX_MISC);
    const int tid = threadIdx.x, lane = tid & 63, wave = __builtin_amdgcn_readfirstlane(tid >> 6), G = gridDim.x;
    unsigned char* ws = args.ws;
    if (tid < 64) MISC[tid] = 0u;
    __syncthreads();
    XcdBarrier bar; bar.bar = (unsigned*)(ws + WS_CTL) + CW_BAR; bar.x = 0; bar.st = nullptr;
    if (!MK_MULTI) bar = xcd_barrier_post((unsigned*)(ws + WS_CTL) + CW_BAR, MISC + 8);
    const int lo = args.ph_lo, hi = args.ph_hi;
#ifndef PH_REPEAT
#define PH_REPEAT 0
#endif
#define IN(k) (lo <= (k) && (k) < hi)
#define SEAM(k) do { if (IN(k) && IN((k) + 1)) xcd_barrier(bar); } while (0)
#define REP(k) for (int rep_ = 0; rep_ < (((PH_REPEAT >> (k)) & 1) ? 2 : 1); ++rep_, (((PH_REPEAT >> (k)) & 1) && rep_ == 1 ? xcd_barrier(bar) : (void)0))
    const float* mod = (const float*)(ws + WS_MOD);
    bf16* Hb = (bf16*)(ws + WS_H);

#ifndef PAD_NOPS
#define PAD_NOPS 0
#endif
    if (PAD_NOPS > 0 && G == 0x7fffffff) { _Pragma("unroll") for (int pn_ = 0; pn_ < PAD_NOPS; ++pn_) asm volatile("s_nop 0"); }
    if (IN(0)) { REP(0) { p0_phase(args, lds, tid, lane, wave, G); } SEAM(0); }
    if (IN(1)) { REP(1) { norm_quant_phase(inp(0), (unsigned char*)Hb, (float*)(ws + WS_SA1), mod, lane, wave, G); } SEAM(1); }
    if (IN(2)) { REP(2) {
        pg8::MoeStream MS{(const unsigned char*)Hb, ws + WS_WINQ, (const float*)(ws + WS_SWIN), (bf16*)(ws + WS_PROJ), nullptr, nullptr, (const float*)(ws + WS_SA1), nullptr, nullptr, nullptr, nullptr, nullptr, nullptr, 0};
        MS.order.init(T, INC, G, (int)blockIdx.x);
        pg8::moe_stream<2>(lds, MS);
        } SEAM(2);
    }
    if (IN(3)) { REP(3) { for (int u = blockIdx.x; u < NB * 32; u += G) p3_unit(args, lds, u, tid, lane, wave); } SEAM(3); }
    if (IN(4)) { REP(4) {
        pg8::Gemm g{(const bf16*)(ws + WS_CAT), (const bf16*)(ws + WS_WOUT), T, D, D};
        bf16* H2 = Hb;
        for (int rnd = 0; rnd * G < (T / 256) * (D / 256); ++rnd) {
            pg8::RoundSched S; S.base.init(T, D, G, (int)blockIdx.x); S.round = rnd;
            pg8::EpiResidNorm E{inp(0), args.out, mod, H2, (float*)(ws + WS_LOGITS), (unsigned*)(ws + WS_CTL) + CW_PANEL + rnd * 128 * 64, EPS};
            pg8::gemm_phase<pg8::EpiResidNorm, pg8::RoundSched, false, true>(lds, g, S, E);
        }
        } SEAM(5);
    }
    if (IN(6)) { REP(6) {
        for (int uu = blockIdx.x; uu < T / 256; uu += G) {
            pg8::Gemm g{Hb, (const bf16*)(ws + WS_WRS), T, 256, D}; pg8::OneUnit S{uu, 0};
            pg8::EpiRouterShared E{(float*)(ws + WS_LOGITS), nullptr};
            pg8::gemm_phase<pg8::EpiRouterShared, pg8::OneUnit, true, true>(lds, g, S, E);
            __syncthreads();
        }
        for (int uu = (int)blockIdx.x < T / 256 ? (int)blockIdx.x + ((T / 256 + G - 1 - (int)blockIdx.x) / G) * G : (int)blockIdx.x; uu < 2 * (T / 256); uu += G)
            quant_rows(Hb, ws + WS_H2Q, (float*)(ws + WS_SA), (LAS float*)(lds + LX_RS), (uu - T / 256) * 256, lane, wave);
        } SEAM(6);
    }
    if (IN(7)) { REP(7) { p7_phase(args, lds, tid, lane, wave, G); } SEAM(7); }
    if (IN(9)) { REP(9) {
        const int fc = build_tiles(args, lds, tid), nfull = fc >> 16, ncheap = fc & 0xffff;
        const LAS unsigned short* texp = (const LAS unsigned short*)(lds + LX_TEXP);
        int xq = 0, wi = blockIdx.x, step = G, sh = 0;
        if ((G & 7) == 0) { xq = blockIdx.x & 7; wi = blockIdx.x >> 3; step = G >> 3; sh = 3; }
        const int f_lo = (int)(((long)xq * nfull) >> sh), f_hi = (int)(((long)(xq + 1) * nfull) >> sh), c_lo = (int)(((long)xq * ncheap) >> sh), c_hi = (int)(((long)(xq + 1) * ncheap) >> sh);
        const int nF = f_hi - f_lo, nC = c_hi - c_lo;
        const int nf = wi < nF ? (nF - wi + step - 1) / step : 0;
        const int j0 = (((wi - nF) % step) + step) % step;
        const int nc = j0 < nC ? (nC - j0 + step - 1) / step : 0;
        const int ntl = nf + nc;
        LAS unsigned short* mt = (LAS unsigned short*)(lds + LX_MY); LAS unsigned short* mr = mt + 16;
        for (int tl0 = 0; tl0 < ntl; tl0 += 6) {
            const int nn = (ntl - tl0) < 6 ? (ntl - tl0) : 6;
            if (tid < nn) { const int idx = tl0 + tid; const int t = idx < nf ? (int)((const LAS unsigned short*)(lds + LX_FT))[f_lo + wi + step * idx] : (int)((const LAS unsigned short*)(lds + LX_CT))[c_lo + j0 + step * (idx - nf)];
                const int ex = (int)texp[t]; int R = ((const LAS int*)(lds + LX_CNT))[ex] - (t * 256 - ((const LAS int*)(lds + LX_BASE))[ex]); R = R > 256 ? 256 : R; mt[tid] = (unsigned short)t; mr[tid] = (unsigned short)R; }
            __syncthreads();
            LAS unsigned short* gl = (LAS unsigned short*)(lds + LX_GL);
            for (int i = tid; i < nn * 256; i += NTHR) { const int sl = i >> 8, r = i & 255, pm = (int)mt[sl]; const int ex = (int)texp[pm], r0 = pm * 256 - ((const LAS int*)(lds + LX_BASE))[ex];
                const bool realr = r < (int)mr[sl];
                const unsigned short tk = !realr ? (unsigned short)0 : (ex == NE ? (unsigned short)(r0 + r) : ((const unsigned short*)(ws + WS_LIST))[(size_t)ex * T + r0 + r]);
                gl[i] = tk; ((LAS float*)(lds + LX_RS))[i] = ((const float*)(ws + WS_SA))[tk];
            }
            for (int i = tid; i < nn * 512; i += NTHR) ((LAS float*)(lds + LX_DST))[i] = ((const float*)(ws + WS_SWGU))[(size_t)texp[mt[i >> 9]] * 512 + (i & 511)];
            if (tid < nn * 8) ((LAS float*)(lds + LX_MY + 64))[tid] = ((const float*)(ws + WS_SWD))[(size_t)texp[mt[tid >> 3]] * 8 + (tid & 7)];
            __syncthreads();
            pg8::MoeStream MS{ws + WS_H2Q, ws + WS_WGU, (const float*)(ws + WS_SWGU), (bf16*)(ws + WS_HID), nullptr, nullptr, nullptr, nullptr, texp, gl, (const LAS float*)(lds + LX_RS), mt, mr, nn}; MS.lsc = (const LAS float*)(lds + LX_DST);
            pg8::moe_stream<0>(lds, MS);
#ifdef PROBE_G1
            __syncthreads(); pg8::moe_stream<0, PROBE_G1>(lds, MS);
#endif
            asm volatile("s_waitcnt vmcnt(0)" ::: "memory"); __syncthreads();
            for (int i = tid; i < nn * 256; i += NTHR) { const int sl = i >> 8, r = i & 255, pm = (int)mt[sl]; const int ex = (int)texp[pm], r0 = pm * 256 - ((const LAS int*)(lds + LX_BASE))[ex];
                ((LAS int*)(lds + LX_DST))[i] = r >= (int)mr[sl] ? -1 : (int)gl[i] * NSLOT + (ex == NE ? TOPK : (int)(ws + WS_SLOT)[(size_t)ex * T + r0 + r]); }
            {
                const bf16* hidp = (const bf16*)(ws + WS_HID); unsigned char* hq = ws + WS_HIDQ; LAS float* rsl = (LAS float*)(lds + LX_RS);
                const int l16 = lane & 15;
                for (int rb = wave * 4 + (lane >> 4); rb < nn * 256; rb += NWAVES * 4 * 4) {
                    v4u a0[4], a1[4]; size_t grow[4];
#pragma unroll
                    for (int u4 = 0; u4 < 4; ++u4) { const int rr = rb + u4 * NWAVES * 4; const int rc = rr < nn * 256 ? rr : rb; const int sl = rc >> 8, r = rc & 255; grow[u4] = (size_t)mt[sl] * 256 + r;
                        const GAS v4u* sp = (const GAS v4u*)(hidp + grow[u4] * 256 + 16 * l16); a0[u4] = sp[0]; a1[u4] = sp[1]; }
#pragma unroll
                    for (int u4 = 0; u4 < 4; ++u4) { const int rr = rb + u4 * NWAVES * 4;
                        float v[16];
                        v[0] = bflo(a0[u4].x); v[1] = bfhi(a0[u4].x); v[2] = bflo(a0[u4].y); v[3] = bfhi(a0[u4].y); v[4] = bflo(a0[u4].z); v[5] = bfhi(a0[u4].z); v[6] = bflo(a0[u4].w); v[7] = bfhi(a0[u4].w);
                        v[8] = bflo(a1[u4].x); v[9] = bfhi(a1[u4].x); v[10] = bflo(a1[u4].y); v[11] = bfhi(a1[u4].y); v[12] = bflo(a1[u4].z); v[13] = bfhi(a1[u4].z); v[14] = bflo(a1[u4].w); v[15] = bfhi(a1[u4].w);
                        float mxv = 0.f;
#pragma unroll
                        for (int i = 0; i < 16; ++i) mxv = fmaxf(mxv, fabsf(v[i]));
                        mxv = dpp16_max(mxv);
                        const float sc = mxv > 0.f ? mxv * (1.0f / 127.0f) : 1.0f, iv = 1.0f / sc;
                        unsigned q[4];
#pragma unroll
                        for (int w4 = 0; w4 < 4; ++w4) { unsigned pk = 0u;
#pragma unroll
                            for (int b = 0; b < 4; ++b) { int qi = (int)rintf(v[4 * w4 + b] * iv); qi = qi > 127 ? 127 : (qi < -127 ? -127 : qi); pk |= ((unsigned)qi & 0xffu) << (8 * b); }
                            q[w4] = pk; }
                        if (rr < nn * 256 && (rr & 255) < (int)mr[rr >> 8]) { *(GAS v4u*)(hq + grow[u4] * 256 + 16 * l16) = (v4u){q[0], q[1], q[2], q[3]};
                            if (l16 == 0) rsl[rr] = sc; } }
                }
                asm volatile("s_waitcnt vmcnt(0)" ::: "memory"); __syncthreads();
            }
            {
                pg8::MoeStream MD{nullptr, nullptr, nullptr, nullptr, ws + WS_HIDQ, ws + WS_WD, (const float*)(ws + WS_SWD), ws + WS_Y, texp, nullptr, (const LAS float*)(lds + LX_RS), mt, mr, nn}; MD.dst = (const LAS int*)(lds + LX_DST); MD.lsc = (const LAS float*)(lds + LX_MY + 64);
                pg8::moe_stream<1>(lds, MD);
#ifdef PROBE_G2
                __syncthreads(); pg8::moe_stream<1, PROBE_G2>(lds, MD);
#endif
            }
            __syncthreads();
        }
        } SEAM(10);
    }
    if (IN(11)) { REP(11) { p11_phase(args, lds, tid, lane, wave, G); } }
#undef IN
#undef SEAM
}

extern "C" void kernel_launch(void* const* d_in, const int* in_sizes, int n_in, void* d_out, int out_size, void* d_ws, size_t ws_size, hipStream_t stream) {
    static int grid = 0;
    if (grid == 0) {
        if (n_in != 22 || in_sizes[0] != T * D || out_size != T * D || ws_size < WS_NEED) { fprintf(stderr, "kernel_launch: unexpected shapes (n_in %d, in0 %d, out %d, ws %zu); nothing launched\n", n_in, n_in > 0 ? in_sizes[0] : -1, out_size, ws_size); grid = -1; return; }
        int dev = 0, cus = 0, per_cu = 0;
        if (hipGetDevice(&dev) != hipSuccess || hipDeviceGetAttribute(&cus, hipDeviceAttributeMultiprocessorCount, dev) != hipSuccess) { grid = -1; return; }
        if (hipFuncSetAttribute((const void*)hyb_fwd, hipFuncAttributeMaxDynamicSharedMemorySize, LDS_BYTES) != hipSuccess) { fprintf(stderr, "kernel_launch: hipFuncSetAttribute failed\n"); grid = -1; return; }
        if (hipOccupancyMaxActiveBlocksPerMultiprocessor(&per_cu, (const void*)hyb_fwd, NTHR, LDS_BYTES) != hipSuccess || per_cu < 1) { fprintf(stderr, "kernel_launch: occupancy query says %d\n", per_cu); }
        (void)hipGetLastError();
        grid = cus;
    }
    if (grid < 0) return;
    if (hipMemsetAsync((char*)d_ws + WS_CTL, 0, CTL_ZERO_BYTES, stream) != hipSuccess) return;
    Args a{};
    for (int i = 0; i < 22; ++i) a.in[i] = (const float*)d_in[i];
    a.out = (float*)d_out; a.ws = (unsigned char*)d_ws;
#if MK_MULTI
#ifndef HOST_REPEAT
#define HOST_REPEAT 0
#endif
    for (int p = 0; p < NPHASE; ++p) for (int r = 0; r < (((HOST_REPEAT >> p) & 1) ? 2 : 1); ++r) { a.ph_lo = p; a.ph_hi = p + 1;
        const bool rep = ((HOST_REPEAT >> p) & 1) != 0;
        a.aux = ((p == 11 || p == 9) && rep && r == 0) ? 1 : 0;
        if (p == 7 && rep && r == 1) (void)hipMemsetAsync((char*)d_ws + WS_CTL + CW_COUNTS * 4, 0, 256 * 64 * 4, stream);
        hipLaunchKernelGGL(hyb_fwd, dim3(grid), dim3(NTHR), LDS_BYTES, stream, a); }
#else
    a.ph_lo = 0; a.ph_hi = NPHASE;
    hipLaunchKernelGGL(hyb_fwd, dim3(grid), dim3(NTHR), LDS_BYTES, stream, a);
#endif
}
```

```cpp
#include <hip/hip_runtime.h>
#include <cstdio>
#include <cstdint>

namespace pg8 {
#define PG8_LAS __attribute__((address_space(3)))
typedef unsigned short bf16_t;
typedef short bf16x8 __attribute__((ext_vector_type(8)));
typedef float f32x4 __attribute__((ext_vector_type(4)));
typedef unsigned u32x4 __attribute__((ext_vector_type(4)));
constexpr int BM = 256, BK = 64, HALF = 128, HTB = HALF * BK * 2  , STAGE_BYTES = 8 * HTB, NXCD = 8, WGM = 8;

__host__ __device__ __forceinline__ int lds_byte(int r, int c) { const int st = (r >> 4) * 2 + (c >> 5), rr = r & 15, cc = c & 31, ob = rr * 64 + cc * 2; return st * 1024 + (ob ^ (((ob >> 9) & 1) << 5)); }
__host__ __device__ __forceinline__ void stage_rc(int b, int& R, int& C) { const int st = b / 1024, sb = b % 1024, swz = sb ^ (((sb >> 9) & 1) << 5); R = (st >> 1) * 16 + swz / 64; C = (st & 1) * 32 + (swz % 64) / 2; }
__host__ __device__ __forceinline__ int perm32(int rho) { const int n = rho >> 4, i = rho & 15; return 8 * (i >> 2) + 4 * n + (i & 3); }

struct Unit { int pm, pn; };
struct Gemm { const bf16_t* A; const bf16_t* Bt; int M, N, K; };

struct StaticOrder {
    int nM, nN, nwg, G, c;
    __host__ __device__ void init(int M, int N, int G_, int c_) { nM = M / BM; nN = N / BM; nwg = nM * nN; G = G_; c = c_; }
    __host__ __device__ bool next(int i, Unit& u) const {
        const long L = (long)i * G + c; if (L >= nwg) return false;
        int wgid = (int)L; { const int q = nwg / NXCD, r = nwg % NXCD, xcd = wgid % NXCD, off = wgid / NXCD; wgid = (xcd < r ? xcd * (q + 1) : r * (q + 1) + (xcd - r) * q) + off; }
        const int nig = WGM * nN, gid = wgid / nig, fm = gid * WGM, gsz = (nM - fm) < WGM ? (nM - fm) : WGM;
        u.pm = fm + ((wgid % nig) % gsz); u.pn = (wgid % nig) / gsz; return true;
    }
    __device__ __forceinline__ void a_ready(const Unit&) const {}
    __device__ __forceinline__ void done(const Unit&) const {}
};

__device__ __forceinline__ unsigned cvt_pk_bf16(float lo, float hi) { unsigned r; asm volatile("v_cvt_pk_bf16_f32 %0, %1, %2" : "=v"(r) : "v"(lo), "v"(hi)); return r; }
typedef float f32x2 __attribute__((ext_vector_type(2)));

typedef float f32x2v __attribute__((ext_vector_type(2)));
typedef __bf16 bf16x2v __attribute__((ext_vector_type(2)));
__device__ __forceinline__ unsigned pkbf(float lo, float hi) { f32x2v v = {lo, hi}; bf16x2v b = __builtin_convertvector(v, bf16x2v); return __builtin_bit_cast(unsigned, b); }
__device__ __forceinline__ float silu_f(float x) { return x * __builtin_amdgcn_rcpf(1.0f + __expf(-x)); }
__device__ __forceinline__ u32x4 pack8(const f32x4& v0, const f32x4& v1) { u32x4 w; w.x = pkbf(v0[0], v0[1]); w.y = pkbf(v0[2], v0[3]); w.z = pkbf(v1[0], v1[1]); w.w = pkbf(v1[2], v1[3]); return w; }

struct EpiBf16 {
    static constexpr bool PERM = true, AFTER_DRAIN = false;
    bf16_t* O; int ldc; int cmask;
    __device__ __forceinline__ void operator()(const f32x4 (&acc)[2][2][4][2], const Unit& u, int wr, int wc, int fr, int fq) const {
        const int row0 = u.pm * BM + wr * 64 + fr, col0 = (u.pn & cmask) * BM + wc * 32 + 8 * fq;
#pragma unroll
        for (int ai = 0; ai < 2; ++ai)
#pragma unroll
            for (int m = 0; m < 4; ++m) { bf16_t* rowp = O + (size_t)(row0 + ai * HALF + m * 16) * ldc + col0;
#pragma unroll
                for (int bj = 0; bj < 2; ++bj) *(u32x4*)(rowp + bj * HALF) = pack8(acc[ai][bj][m][0], acc[ai][bj][m][1]); }
    }
};
struct EpiFp8 {
    static constexpr bool PERM = true, AFTER_DRAIN = false;
    unsigned char* O; int ldc; int cmask;
    __device__ __forceinline__ void operator()(const f32x4 (&acc)[2][2][4][2], const Unit& u, int wr, int wc, int fr, int fq) const {
        const int row0 = u.pm * BM + wr * 64 + fr, col0 = (u.pn & cmask) * BM + wc * 64 + 16 * fq;
#pragma unroll
        for (int ai = 0; ai < 2; ++ai)
#pragma unroll
            for (int m = 0; m < 4; ++m) { u32x4 w;
#pragma unroll
                for (int bj = 0; bj < 2; ++bj)
#pragma unroll
                    for (int n = 0; n < 2; ++n) { const f32x4 v = acc[ai][bj][m][n];
                        int t = __builtin_amdgcn_cvt_pk_fp8_f32(v[0], v[1], 0, false); t = __builtin_amdgcn_cvt_pk_fp8_f32(v[2], v[3], t, true); w[2 * bj + n] = (unsigned)t; }
                *(u32x4*)(O + (size_t)(row0 + ai * HALF + m * 16) * ldc + col0) = w; asm volatile("" ::: "memory"); }
    }
};
struct OneUnit {
    int pm, pn;
    __device__ __forceinline__ bool next(int i, Unit& u) const { if (i) return false; u.pm = pm; u.pn = pn; return true; }
    __device__ __forceinline__ void a_ready(const Unit&) const {}
    __device__ __forceinline__ void done(const Unit&) const {}
};
struct EpiResid {
    static constexpr bool PERM = true, AFTER_DRAIN = false;
    const float* x; float* out; const float* gate;
    __device__ __forceinline__ void operator()(const f32x4 (&acc)[2][2][4][2], const Unit& u, int wr, int wc, int fr, int fq) const {
        const int row0 = u.pm * BM + wr * 64 + fr, col0 = u.pn * BM + wc * 32 + 8 * fq;
        const float* gp = gate + (size_t)((u.pm * BM) >> 12) * 6144 + col0;
        f32x4 gv[2][2];
#pragma unroll
        for (int bj = 0; bj < 2; ++bj)
#pragma unroll
            for (int n = 0; n < 2; ++n) gv[bj][n] = *(const f32x4*)(gp + bj * HALF + 4 * n);
#pragma unroll
        for (int ai = 0; ai < 2; ++ai)
#pragma unroll
            for (int m = 0; m < 4; ++m) { const size_t off = (size_t)(row0 + ai * HALF + m * 16) * 1024 + col0;
#pragma unroll
                for (int bj = 0; bj < 2; ++bj)
#pragma unroll
                    for (int n = 0; n < 2; ++n) { const f32x4 xv = *(const f32x4*)(x + off + bj * HALF + 4 * n); *(f32x4*)(out + off + bj * HALF + 4 * n) = xv + gv[bj][n] * acc[ai][bj][m][n]; } }
    }
};
__device__ __forceinline__ void store_gateup(const f32x4 (&acc)[2][2][4][2], bf16_t* hid, int row0, int j, int wc, int fq) {
#pragma unroll
    for (int ai = 0; ai < 2; ++ai)
#pragma unroll
        for (int m = 0; m < 4; ++m) { f32x4 h0, h1;
#pragma unroll
            for (int e = 0; e < 4; ++e) { h0[e] = silu_f(acc[ai][0][m][0][e]) * acc[ai][1][m][0][e]; h1[e] = silu_f(acc[ai][0][m][1][e]) * acc[ai][1][m][1][e]; }
            *(u32x4*)(hid + (size_t)(row0 + ai * HALF + m * 16) * 256 + 128 * j + wc * 32 + 8 * fq) = pack8(h0, h1); asm volatile("" ::: "memory"); }
}
struct EpiRouterShared {
    static constexpr bool PERM = true, AFTER_DRAIN = false;
    float* logits; bf16_t* hid;
    __device__ __forceinline__ void operator()(const f32x4 (&acc)[2][2][4][2], const Unit& u, int wr, int wc, int fr, int fq) const {
        const int row0 = u.pm * BM + wr * 64 + fr;
        if (u.pn == 0) {
#pragma unroll
            for (int ai = 0; ai < 2; ++ai)
#pragma unroll
                for (int m = 0; m < 4; ++m) { float* rowp = logits + (size_t)(row0 + ai * HALF + m * 16) * 256 + wc * 32 + 8 * fq;
#pragma unroll
                    for (int bj = 0; bj < 2; ++bj)
#pragma unroll
                        for (int n = 0; n < 2; ++n) *(f32x4*)(rowp + bj * HALF + 4 * n) = acc[ai][bj][m][n]; }
        } else store_gateup(acc, hid, row0, u.pn - 1, wc, fq);
    }
};
struct EpiRouterHalf {
    static constexpr bool PERM = true, AFTER_DRAIN = false;
    float* logits;
    __device__ __forceinline__ void operator()(const f32x4 (&acc)[2][2][4][2], const Unit& u, int wr, int wc, int fr, int fq) const {
#pragma unroll
        for (int m = 0; m < 4; ++m) { float* rowp = logits + (size_t)(u.pm * BM + wr * 64 + fr + m * 16) * 256 + wc * 32 + 8 * fq;
#pragma unroll
            for (int bj = 0; bj < 2; ++bj)
#pragma unroll
                for (int n = 0; n < 2; ++n) *(f32x4*)(rowp + bj * HALF + 4 * n) = acc[0][bj][m][n]; }
    }
};
struct EpiGateUp {
    static constexpr bool PERM = true, AFTER_DRAIN = false;
    bf16_t* hid;
    __device__ __forceinline__ void operator()(const f32x4 (&acc)[2][2][4][2], const Unit& u, int wr, int wc, int fr, int fq) const {
        store_gateup(acc, hid, u.pm * BM + wr * 64 + fr, u.pn & 1, wc, fq);
    }
};
struct EpiDownScatter {
    static constexpr bool PERM = true, AFTER_DRAIN = false;
    bf16_t* y; const int* rowdst; const float* roww;
    __device__ __forceinline__ void operator()(const f32x4 (&acc)[2][2][4][2], const Unit& u, int wr, int wc, int fr, int fq) const {
        const int row0 = u.pm * BM + wr * 64 + fr, col0 = (u.pn & 3) * BM + wc * 32 + 8 * fq;
#pragma unroll
        for (int ai = 0; ai < 2; ++ai) {
            int d[4]; float w[4];
#pragma unroll
            for (int m = 0; m < 4; ++m) { const int p = row0 + ai * HALF + m * 16; d[m] = rowdst[p]; w[m] = roww[p]; }
#pragma unroll
            for (int m = 0; m < 4; ++m) { bf16_t* rowp = y + (size_t)d[m] * 1024 + col0;
#pragma unroll
                for (int bj = 0; bj < 2; ++bj) *(u32x4*)(rowp + bj * HALF) = pack8(acc[ai][bj][m][0] * w[m], acc[ai][bj][m][1] * w[m]); }
            asm volatile("" ::: "memory"); }
    }
};

struct EpiResidNorm {
    static constexpr bool PERM = true, AFTER_DRAIN = true;
    const float* x; float* out; const float* mod  ; bf16_t* h2; float* slots  ; unsigned* cnt  ; float eps;
    __device__ __forceinline__ void operator()(const f32x4 (&)[2][2][4][2], const Unit&, int, int, int, int) const {}
    __device__ __forceinline__ void fused(f32x4 (&acc)[2][2][4][2], const Unit& u, int wr, int wc, int fr, int fq, PG8_LAS unsigned char* lds, int wid, int lane) const {
        PG8_LAS float* P = (PG8_LAS float*)lds;
        PG8_LAS float* Sv = (PG8_LAS float*)(lds + 4096);
        const int row0 = u.pm * BM + wr * 64 + fr, col0 = u.pn * BM + wc * 32 + 8 * fq;
        const float* mb = mod + (size_t)((u.pm * BM) >> 12) * 6144;
        {
            f32x4 gv[2][2];
#pragma unroll
            for (int bj = 0; bj < 2; ++bj)
#pragma unroll
                for (int n = 0; n < 2; ++n) gv[bj][n] = *(const f32x4*)(mb + 2048 + col0 + bj * HALF + 4 * n);
            f32x4 xb[2][2][2];
#pragma unroll
            for (int bj = 0; bj < 2; ++bj)
#pragma unroll
                for (int n = 0; n < 2; ++n) xb[0][bj][n] = *(const f32x4*)(x + (size_t)row0 * 1024 + col0 + bj * HALF + 4 * n);
#pragma unroll
            for (int blk = 0; blk < 8; ++blk) { const int ai = blk >> 2, m = blk & 3; const size_t off = (size_t)(row0 + ai * HALF + m * 16) * 1024 + col0; float s = 0.f;
                if (blk < 7) { const size_t offn = (size_t)(row0 + ((blk + 1) >> 2) * HALF + ((blk + 1) & 3) * 16) * 1024 + col0;
#pragma unroll
                    for (int bj = 0; bj < 2; ++bj)
#pragma unroll
                        for (int n = 0; n < 2; ++n) xb[(blk + 1) & 1][bj][n] = *(const f32x4*)(x + offn + bj * HALF + 4 * n); }
#pragma unroll
                for (int bj = 0; bj < 2; ++bj) {
#pragma unroll
                    for (int n = 0; n < 2; ++n) { const f32x4 v = xb[blk & 1][bj][n] + gv[bj][n] * acc[ai][bj][m][n]; acc[ai][bj][m][n] = v;
                        s += (v[0] * v[0] + v[1] * v[1]) + (v[2] * v[2] + v[3] * v[3]); }
                    *(u32x4*)((bf16_t*)out + 2 * (off - col0) + col0 + bj * HALF) = pack8(acc[ai][bj][m][0], acc[ai][bj][m][1]); }
                s += __shfl_xor(s, 16); s += __shfl_xor(s, 32);
                if (fq == 0) P[(ai * HALF + wr * 64 + m * 16 + fr) * 4 + wc] = s; }
        }
        asm volatile("s_waitcnt lgkmcnt(0)" ::: "memory"); __builtin_amdgcn_s_barrier(); asm volatile("" ::: "memory");
        const int row = wid * 32 + (lane & 31);
        if (lane < 32) { const float tot = (P[row * 4 + 0] + P[row * 4 + 1]) + (P[row * 4 + 2] + P[row * 4 + 3]);
            __hip_atomic_store(slots + (size_t)(u.pm * BM + row) * 4 + u.pn, tot, __ATOMIC_RELAXED, __HIP_MEMORY_SCOPE_AGENT); }
        asm volatile("s_waitcnt vmcnt(0)" ::: "memory");
        if (lane == 0) __hip_atomic_fetch_add(cnt + 64 * u.pm, 1u, __ATOMIC_RELAXED, __HIP_MEMORY_SCOPE_AGENT);
        if (wid == 0) {
            unsigned spins = 0;
            while ((unsigned)__builtin_amdgcn_readfirstlane((int)__hip_atomic_load(cnt + 64 * u.pm, __ATOMIC_RELAXED, __HIP_MEMORY_SCOPE_AGENT)) < 32u) { __builtin_amdgcn_s_sleep(2); if (++spins > (1u << 22)) break; }
            asm volatile("s_waitcnt vmcnt(0)" ::: "memory");
        }
        asm volatile("s_waitcnt vmcnt(0) lgkmcnt(0)" ::: "memory"); __builtin_amdgcn_s_barrier(); asm volatile("" ::: "memory");
        if (lane < 32) { const float* sl = slots + (size_t)(u.pm * BM + row) * 4; float t4[4];
#pragma unroll
            for (int t = 0; t < 4; ++t) t4[t] = __hip_atomic_load(sl + t, __ATOMIC_RELAXED, __HIP_MEMORY_SCOPE_AGENT);
            Sv[row] = 1.0f / sqrtf(((t4[0] + t4[1]) + (t4[2] + t4[3])) * (1.0f / 1024.0f) + eps); }
        asm volatile("s_waitcnt lgkmcnt(0)" ::: "memory"); __builtin_amdgcn_s_barrier(); asm volatile("" ::: "memory");
        f32x4 shv[2][2], scv[2][2];
#pragma unroll
        for (int bj = 0; bj < 2; ++bj)
#pragma unroll
            for (int n = 0; n < 2; ++n) { shv[bj][n] = *(const f32x4*)(mb + 3072 + col0 + bj * HALF + 4 * n); scv[bj][n] = *(const f32x4*)(mb + 4096 + col0 + bj * HALF + 4 * n) + 1.0f; }
#pragma unroll
        for (int ai = 0; ai < 2; ++ai)
#pragma unroll
            for (int m = 0; m < 4; ++m) { const int r = ai * HALF + wr * 64 + m * 16 + fr; const float rs = Sv[r]; bf16_t* rowp = h2 + (size_t)(u.pm * BM + r) * 1024 + col0;
#pragma unroll
                for (int bj = 0; bj < 2; ++bj) *(u32x4*)(rowp + bj * HALF) = pack8(acc[ai][bj][m][0] * rs * scv[bj][0] + shv[bj][0], acc[ai][bj][m][1] * rs * scv[bj][1] + shv[bj][1]); }
    }
};
struct RoundSched {
    StaticOrder base; int round;
    __device__ __forceinline__ bool next(int i, Unit& u) const { if (i) return false; return base.next(round, u); }
    __device__ __forceinline__ void a_ready(const Unit&) const {}
    __device__ __forceinline__ void done(const Unit&) const {}
};
struct TileSched {
    const PG8_LAS unsigned short* tile_exp; int first, step, hi, sh;
    __device__ __forceinline__ bool next(int i, Unit& u) const {
        const int L = first + step * i; if (L >= hi) return false;
        const int pm = L >> sh; u.pm = pm; u.pn = (__builtin_amdgcn_readfirstlane((int)tile_exp[pm]) << sh) + (L & ((1 << sh) - 1)); return true;
    }
    __device__ __forceinline__ void a_ready(const Unit&) const {}
    __device__ __forceinline__ void done(const Unit&) const {}
};

template <class Epi, class Sched, bool ALIGN_EPI = false, bool SP2 = false, bool GATHER = false, bool HALFM = false>
__device__ __forceinline__ void gemm_phase(PG8_LAS unsigned char* lds, const Gemm g, const Sched& S, const Epi& E, const unsigned short* glist = nullptr, int gcnt = 0) {
    const int tid = threadIdx.x, wid = __builtin_amdgcn_readfirstlane(tid >> 6), lane = tid & 63, wr = wid >> 2, wc = wid & 3, fr = lane & 15, fq = lane >> 4;
    const int K = g.K, nt = K / BK;
    unsigned voffA[2], voffA1[2], voffB[2];
#pragma unroll
    for (int i = 0; i < 2; ++i) { int R, C; stage_rc(tid * 16 + i * 8192, R, C); const int Rb = Epi::PERM ? ((R & ~31) + perm32(R & 31)) : R;
        voffA[i] = (unsigned)(R * K + C) * 2u; voffA1[i] = voffA[i]; voffB[i] = (unsigned)(Rb * K + C) * 2u;
        if constexpr (GATHER) {
            const int ra = R < gcnt ? (int)glist[R] : 0, rb = (HALF + R) < gcnt ? (int)glist[HALF + R] : 0;
            voffA[i] = (unsigned)(ra * K + C) * 2u; voffA1[i] = (unsigned)(rb * K + C) * 2u; } }
    const size_t kstep = (size_t)(BK * 2);
    const size_t hstep = (size_t)HALF * K * 2;
    const size_t tstep = 2 * hstep;
    const size_t hstepA = GATHER ? 0 : hstep, tstepA = GATHER ? 0 : tstep;
    const unsigned ldsw = (unsigned)wid * 1024u;
    const int aoff = lds_byte(wr * 64 + fr, fq * 8), boff = lds_byte(wc * 32 + fr, fq * 8);
#define PG8_SA(b, h) (((b) * 2 + (h)) * HTB)
#define PG8_SB(b, h) ((4 + (b) * 2 + (h)) * HTB)
#define PG8_STAGE(bufoff, gbase, voff) do { _Pragma("unroll") for (int _i = 0; _i < 2; ++_i) \
        __builtin_amdgcn_global_load_lds((const unsigned*)((const char*)(gbase) + (voff)[_i]), (PG8_LAS unsigned*)(lds + (bufoff) + ldsw + _i * 8192), 16, 0, 0); } while (0)
#define PG8_LDA(dst, b, h) do { _Pragma("unroll") for (int m = 0; m < 4; ++m) _Pragma("unroll") for (int k = 0; k < 2; ++k) dst[m][k] = *(const PG8_LAS bf16x8*)(lds + PG8_SA(b, h) + aoff + m * 2048 + k * 1024); } while (0)
#define PG8_LDB(dst, b, h) do { _Pragma("unroll") for (int n = 0; n < 2; ++n) _Pragma("unroll") for (int k = 0; k < 2; ++k) dst[n][k] = *(const PG8_LAS bf16x8*)(lds + PG8_SB(b, h) + boff + n * 2048 + k * 1024); } while (0)
#define PG8_MMA(ai, bj, At, Bt) do { __builtin_amdgcn_s_setprio(1); _Pragma("unroll") for (int m = 0; m < 4; ++m) _Pragma("unroll") for (int n = 0; n < 2; ++n) _Pragma("unroll") for (int k = 0; k < 2; ++k) \
        acc[ai][bj][m][n] = __builtin_amdgcn_mfma_f32_16x16x32_bf16(Bt[n][k], At[m][k], acc[ai][bj][m][n], 0, 0, 0); __builtin_amdgcn_s_setprio(0); } while (0)
#define PG8_WAIT_V(n) asm volatile("s_waitcnt vmcnt(" #n ")" ::: "memory")
#define PG8_WAIT_L(n) asm volatile("s_waitcnt lgkmcnt(" #n ")" ::: "memory")
#define PG8_BAR __builtin_amdgcn_s_barrier()
#define PG8_SCHED __builtin_amdgcn_sched_barrier(0)
    Unit cur, nxt; int ui = 0;
    if (!S.next(0, cur)) return;
    f32x4 acc[2][2][4][2];
#pragma unroll
    for (int a = 0; a < 2; ++a)
#pragma unroll
        for (int b = 0; b < 2; ++b)
#pragma unroll
            for (int m = 0; m < 4; ++m)
#pragma unroll
                for (int n = 0; n < 2; ++n) acc[a][b][m][n] = (f32x4){0.f, 0.f, 0.f, 0.f};
    bf16x8 At[4][2], B0[2][2], B1[2][2];
    const char* cA = (const char*)g.A + (size_t)cur.pm * tstepA; const char* cB = (const char*)g.Bt + (size_t)cur.pn * tstep;
    S.a_ready(cur);
    if constexpr (SP2) {
        PG8_STAGE(PG8_SB(0, 0), cB, voffB); PG8_STAGE(PG8_SB(0, 1), cB + hstep, voffB); PG8_STAGE(PG8_SA(0, 0), cA, voffA); PG8_STAGE(PG8_SA(0, 1), cA + hstepA, voffA1);
        if (wr == 1) PG8_BAR;
        PG8_WAIT_V(2); PG8_BAR;
        PG8_STAGE(PG8_SB(1, 0), cB + kstep, voffB); PG8_STAGE(PG8_SA(1, 0), cA + kstep, voffA); PG8_STAGE(PG8_SB(1, 1), cB + hstep + kstep, voffB);
        PG8_WAIT_V(6); PG8_BAR;
    } else {
        PG8_STAGE(PG8_SB(0, 0), cB, voffB); PG8_STAGE(PG8_SA(0, 0), cA, voffA); PG8_STAGE(PG8_SB(0, 1), cB + hstep, voffB); PG8_STAGE(PG8_SA(0, 1), cA + hstepA, voffA1);
        if (wr == 1) PG8_BAR;
        PG8_WAIT_V(4); PG8_BAR;
        PG8_STAGE(PG8_SB(1, 0), cB + kstep, voffB); PG8_STAGE(PG8_SA(1, 0), cA + kstep, voffA); PG8_STAGE(PG8_SB(1, 1), cB + hstep + kstep, voffB);
        PG8_WAIT_V(6); PG8_BAR;
    }
    for (;;) {
        const bool has_next = S.next(ui + 1, nxt);
        const char* nA = has_next ? (const char*)g.A + (size_t)nxt.pm * tstepA : cA; const char* nB = has_next ? (const char*)g.Bt + (size_t)nxt.pn * tstep : cB;
#pragma nounroll
        for (int t = 0; t < nt; t += 2) {
            const bool last = (t == nt - 2);
            const char* a1 = cA + (size_t)(t + 1) * kstep;
            const char* a2 = last ? nA : cA + (size_t)(t + 2) * kstep; const char* b2 = last ? nB : cB + (size_t)(t + 2) * kstep;
            const char* a3 = a2 + kstep; const char* b3 = b2 + kstep;
            if (last && has_next) S.a_ready(nxt);
            if constexpr (SP2) {
            PG8_LDB(B0, 0, 0); PG8_LDB(B1, 0, 1); PG8_SCHED; PG8_LDA(At, 0, 0); PG8_STAGE(PG8_SA(1, 1), a1 + hstepA, voffA1);
            PG8_WAIT_V(8); PG8_WAIT_L(0); PG8_BAR; PG8_MMA(0, 0, At, B0); PG8_MMA(0, 1, At, B1); PG8_BAR; PG8_SCHED;
            if (!HALFM) PG8_LDA(At, 0, 1); PG8_STAGE(PG8_SB(0, 0), b2, voffB); PG8_STAGE(PG8_SB(0, 1), b2 + hstep, voffB); PG8_STAGE(PG8_SA(0, 0), a2, voffA);
            PG8_WAIT_V(8); PG8_WAIT_L(0); PG8_BAR; if (!HALFM) { PG8_MMA(1, 0, At, B0); PG8_MMA(1, 1, At, B1); } PG8_BAR; PG8_SCHED;
            PG8_LDB(B0, 1, 0); PG8_LDB(B1, 1, 1); PG8_SCHED; PG8_LDA(At, 1, 0); PG8_STAGE(PG8_SA(0, 1), a2 + hstepA, voffA1);
            PG8_WAIT_V(8); PG8_WAIT_L(0); PG8_BAR; PG8_MMA(0, 0, At, B0); PG8_MMA(0, 1, At, B1); PG8_BAR; PG8_SCHED;
            if (!HALFM) PG8_LDA(At, 1, 1); PG8_STAGE(PG8_SB(1, 0), b3, voffB); PG8_STAGE(PG8_SB(1, 1), b3 + hstep, voffB); PG8_STAGE(PG8_SA(1, 0), a3, voffA);
            PG8_WAIT_V(8); PG8_WAIT_L(0); PG8_BAR; if (!HALFM) { PG8_MMA(1, 0, At, B0); PG8_MMA(1, 1, At, B1); } PG8_BAR; PG8_SCHED;
            } else {
            PG8_LDB(B0, 0, 0); PG8_SCHED; PG8_LDA(At, 0, 0); PG8_STAGE(PG8_SA(1, 1), a1 + hstepA, voffA1);
            PG8_WAIT_L(8); PG8_BAR; PG8_WAIT_L(0); PG8_MMA(0, 0, At, B0); PG8_BAR; PG8_SCHED;
            PG8_LDB(B1, 0, 1); PG8_STAGE(PG8_SB(0, 0), b2, voffB);
            PG8_BAR; PG8_WAIT_L(0); PG8_MMA(0, 1, At, B1); PG8_BAR;
            PG8_LDA(At, 0, 1); PG8_STAGE(PG8_SA(0, 0), a2, voffA);
            PG8_BAR; PG8_WAIT_L(0); PG8_MMA(1, 0, At, B0); PG8_BAR; PG8_SCHED;
            PG8_STAGE(PG8_SB(0, 1), b2 + hstep, voffB);
            PG8_WAIT_V(6); PG8_BAR; PG8_MMA(1, 1, At, B1); PG8_BAR;
            PG8_LDB(B0, 1, 0); PG8_SCHED; PG8_LDA(At, 1, 0); PG8_STAGE(PG8_SA(0, 1), a2 + hstepA, voffA1);
            PG8_WAIT_L(8); PG8_BAR; PG8_WAIT_L(0); PG8_MMA(0, 0, At, B0); PG8_BAR; PG8_SCHED;
            PG8_LDB(B1, 1, 1); PG8_STAGE(PG8_SB(1, 0), b3, voffB);
            PG8_BAR; PG8_WAIT_L(0); PG8_MMA(0, 1, At, B1); PG8_BAR;
            PG8_LDA(At, 1, 1); PG8_STAGE(PG8_SA(1, 0), a3, voffA);
            PG8_BAR; PG8_WAIT_L(0); PG8_MMA(1, 0, At, B0); PG8_BAR; PG8_SCHED;
            PG8_STAGE(PG8_SB(1, 1), b3 + hstep, voffB);
            PG8_WAIT_V(6); PG8_BAR; PG8_MMA(1, 1, At, B1); PG8_BAR;
            }
        }
        if constexpr (ALIGN_EPI) { if (wr == 0) PG8_BAR; }
        if constexpr (!Epi::AFTER_DRAIN) { E(acc, cur, wr, wc, fr, fq); S.done(cur); }
        if (!has_next) break;
#pragma unroll
        for (int a = 0; a < 2; ++a)
#pragma unroll
            for (int b = 0; b < 2; ++b)
#pragma unroll
                for (int m = 0; m < 4; ++m)
#pragma unroll
                    for (int n = 0; n < 2; ++n) acc[a][b][m][n] = (f32x4){0.f, 0.f, 0.f, 0.f};
        cur = nxt; cA = nA; cB = nB; ++ui;
        if constexpr (ALIGN_EPI) { if (wr == 1) PG8_BAR; }
    }
    PG8_WAIT_V(0);
    if constexpr (!ALIGN_EPI) { if (wr == 0) PG8_BAR; }
    PG8_BAR;
    if constexpr (Epi::AFTER_DRAIN) { E.fused(acc, cur, wr, wc, fr, fq, lds, wid, lane); S.done(cur); }
#undef PG8_SA
#undef PG8_SB
#undef PG8_STAGE
#undef PG8_LDA
#undef PG8_LDB
#undef PG8_MMA
#undef PG8_WAIT_V
#undef PG8_WAIT_L
#undef PG8_BAR
#undef PG8_SCHED
}

typedef int i32x4 __attribute__((ext_vector_type(4)));
struct MoeStream {
    const unsigned char* h2q; const unsigned char* wgu8; const float* swgu; bf16_t* hid; const unsigned char* hidq; const unsigned char* wd8; const float* swd; unsigned char* y;
    const PG8_LAS unsigned short* texp;
    const PG8_LAS unsigned short* glist;
    const PG8_LAS float* rscale;
    const PG8_LAS unsigned short* tl;
    const PG8_LAS unsigned short* rl;
    int n;
    const PG8_LAS int* dst;
    const PG8_LAS float* lsc;
    StaticOrder order;
};
struct MUnit { int kind, slot, tile, j, e, rows; };
template <int KIND> __device__ __forceinline__ bool moe_next(const MoeStream& S, int q, MUnit& u) {
    if (KIND == 2) { Unit uu; if (!S.order.next(q, uu)) return false; u.kind = 2; u.slot = 0; u.tile = uu.pm; u.j = uu.pn; u.e = 0; u.rows = 256; return true; }
    if (KIND == 0) { if (q >= 2 * S.n) return false; u.kind = 0; u.slot = q >> 1; u.j = q & 1; }
    else { if (q >= 4 * S.n) return false; u.kind = 1; u.slot = q >> 2; u.j = q & 3; }
    u.tile = __builtin_amdgcn_readfirstlane((int)S.tl[u.slot]); u.rows = __builtin_amdgcn_readfirstlane((int)S.rl[u.slot]); u.e = __builtin_amdgcn_readfirstlane((int)S.texp[u.tile]); return true;
}
template <int KIND, int VAR = 0> __device__ __forceinline__ void moe_stream(PG8_LAS unsigned char* lds, const MoeStream S) {
    int tid_ = threadIdx.x; asm volatile("" : "+v"(tid_));
    const int tid = tid_, wid = __builtin_amdgcn_readfirstlane(tid >> 6), lane = tid & 63, wr = wid >> 2, wc = wid & 3, fr = lane & 15, fq = lane >> 4;
    unsigned voffA[2], voffA1[2], voffB[2];
#define MS_OFFS(u) do { int tidv_ = tid; asm volatile("" : "+v"(tidv_)); _Pragma("unroll") for (int i_ = 0; i_ < 2; ++i_) { int sR[2], sC[2], sRb[2]; stage_rc(tidv_ * 16 + i_ * 8192, sR[i_], sC[i_]); sRb[i_] = (sR[i_] & ~31) + perm32(sR[i_] & 31); \
        if (KIND == 2) { voffA[i_] = (unsigned)(sR[i_] * 1024 + sC[i_] * 2); voffA1[i_] = voffA[i_]; voffB[i_] = (unsigned)(sRb[i_] * 1024 + sC[i_] * 2); } \
        else if (KIND == 0) { const PG8_LAS unsigned short* gl_ = S.glist + (u).slot * 256; \
            voffA[i_] = (unsigned)((int)gl_[sR[i_]] * 1024 + sC[i_] * 2); voffA1[i_] = (unsigned)((int)gl_[HALF + sR[i_]] * 1024 + sC[i_] * 2); voffB[i_] = (unsigned)(sRb[i_] * 1024 + sC[i_] * 2); } \
        else { voffA[i_] = (unsigned)(sR[i_] * 256 + sC[i_] * 2); voffA1[i_] = voffA[i_]; voffB[i_] = (unsigned)(sRb[i_] * 256 + sC[i_] * 2); } } } while (0)
#define MS_PARAMS(u, pA, pB, hA, hB, ntv) do { \
        if (KIND == 2) { pA = (const char*)S.h2q + (size_t)(u).tile * (256 * 1024); hA = (unsigned)(HALF * 1024); pB = (const char*)S.wgu8 + (size_t)(u).j * (256 * 1024); hB = (unsigned)(HALF * 1024); ntv = 8; } \
        else if (KIND == 0) { pA = (const char*)S.h2q; hA = 0u; pB = (const char*)S.wgu8 + (size_t)((u).e * 2 + (u).j) * (256 * 1024); hB = (unsigned)(HALF * 1024); ntv = 8; } \
        else { pA = (const char*)S.hidq + (size_t)(u).tile * (256 * 256); hA = (unsigned)(HALF * 256); pB = (const char*)S.wd8 + (size_t)((u).e * 4 + (u).j) * (256 * 256); hB = (unsigned)(HALF * 256); ntv = 2; } } while (0)
    const size_t kstep = (size_t)(BK * 2);
    const unsigned ldsw = (unsigned)wid * 1024u;
    const int aoff = lds_byte(wr * 64 + fr, fq * 8), boff = lds_byte(wc * 32 + fr, fq * 8);
#define PG8_SA(b, h) (((b) * 2 + (h)) * HTB)
#define PG8_SB(b, h) ((4 + (b) * 2 + (h)) * HTB)
#define PG8_STAGE(bufoff, gbase, voff) do { _Pragma("unroll") for (int _i = 0; _i < 2; ++_i) { unsigned vo_ = (voff)[_i]; asm volatile("" : "+v"(vo_));     \
        __builtin_amdgcn_global_load_lds((const unsigned*)((const char*)(gbase) + vo_), (PG8_LAS unsigned*)(lds + (bufoff) + ldsw + _i * 8192), 16, 0, 0); } } while (0)
#define PG8_LDA(dst, b, h) do { _Pragma("unroll") for (int m = 0; m < 4; ++m) _Pragma("unroll") for (int k = 0; k < 2; ++k) dst[m][k] = *(const PG8_LAS bf16x8*)(lds + PG8_SA(b, h) + aoff + m * 2048 + k * 1024); } while (0)
#define PG8_LDB(dst, b, h) do { _Pragma("unroll") for (int n = 0; n < 2; ++n) _Pragma("unroll") for (int k = 0; k < 2; ++k) dst[n][k] = *(const PG8_LAS bf16x8*)(lds + PG8_SB(b, h) + boff + n * 2048 + k * 1024); } while (0)
#define PG8_MMA(ai, bj, At, Bt) do { __builtin_amdgcn_s_setprio(1); _Pragma("unroll") for (int m = 0; m < 4; ++m) _Pragma("unroll") for (int n = 0; n < 2; ++n) _Pragma("unroll") for (int k = 0; k < 2; ++k) \
        acc[ai][bj][m][n] = __builtin_amdgcn_mfma_f32_16x16x32_bf16(Bt[n][k], At[m][k], acc[ai][bj][m][n], 0, 0, 0); __builtin_amdgcn_s_setprio(0); } while (0)
#define PG8_MMA8(ai, bj, At, Bt) do { __builtin_amdgcn_s_setprio(1); _Pragma("unroll") for (int m = 0; m < 4; ++m) _Pragma("unroll") for (int n = 0; n < 2; ++n) _Pragma("unroll") for (int k = 0; k < 2; ++k) \
        acc[ai][bj][m][n] = __builtin_bit_cast(f32x4, __builtin_amdgcn_mfma_i32_16x16x64_i8(__builtin_bit_cast(i32x4, Bt[n][k]), __builtin_bit_cast(i32x4, At[m][k]), __builtin_bit_cast(i32x4, acc[ai][bj][m][n]), 0, 0, 0)); __builtin_amdgcn_s_setprio(0); } while (0)
#define MS_MMA(ai, bj, At, Bt) PG8_MMA8(ai, bj, At, Bt)
#define PG8_WAIT_V(n) asm volatile("s_waitcnt vmcnt(" #n ")" ::: "memory")
#define MS_WAIT_K do { if (KIND == 1) PG8_WAIT_V(4); else PG8_WAIT_V(8); } while (0)
#define PG8_WAIT_L(n) asm volatile("s_waitcnt lgkmcnt(" #n ")" ::: "memory")
#define PG8_BAR __builtin_amdgcn_s_barrier()
#define PG8_SCHED __builtin_amdgcn_sched_barrier(0)
    MUnit cur, nxt; int ui = 0;
    if (!moe_next<KIND>(S, 0, cur)) return;
    f32x4 acc[2][2][4][2];
#pragma unroll
    for (int a = 0; a < 2; ++a)
#pragma unroll
        for (int b = 0; b < 2; ++b)
#pragma unroll
            for (int m = 0; m < 4; ++m)
#pragma unroll
                for (int n = 0; n < 2; ++n) acc[a][b][m][n] = (f32x4){0.f, 0.f, 0.f, 0.f};
    bf16x8 At[4][2], B0[2][2], B1[2][2];
    const char* cA; const char* cB; unsigned chA, chB; int nt;
    MS_PARAMS(cur, cA, cB, chA, chB, nt);
    asm volatile("" : "+s"(nt));
    MS_OFFS(cur);
    PG8_STAGE(PG8_SB(0, 0), cB, voffB); PG8_STAGE(PG8_SB(0, 1), cB + chB, voffB); PG8_STAGE(PG8_SA(0, 0), cA, voffA); PG8_STAGE(PG8_SA(0, 1), cA + chA, voffA1);
    if (wr == 1) PG8_BAR;
    PG8_WAIT_V(2); PG8_BAR;
    PG8_STAGE(PG8_SB(1, 0), cB + kstep, voffB); PG8_STAGE(PG8_SA(1, 0), cA + kstep, voffA); PG8_STAGE(PG8_SB(1, 1), cB + chB + kstep, voffB);
    PG8_WAIT_V(6); PG8_BAR;
    for (;;) {
        const bool has_next = moe_next<KIND>(S, ui + 1, nxt);
        const char* nA = cA; const char* nB = cB; unsigned nhA = chA, nhB = chB; int nnt = nt;
        if (has_next) MS_PARAMS(nxt, nA, nB, nhA, nhB, nnt);
        const bool new_offs = KIND != 2 && has_next && (nxt.kind != cur.kind || nxt.slot != cur.slot);
        const bool stA_cur = KIND != 1 || cur.j == 0, stA_nxt = KIND != 1 || (has_next && nxt.j == 0);
        const bool act0 = VAR != 3 && (KIND == 2 || cur.rows > 64 * wr), act1 = VAR != 3 && (KIND == 2 || cur.rows > 128 + 64 * wr);
#pragma nounroll
        for (int t = 0; t < nt; t += 2) {
            const bool last = (t == nt - 2);
            const char* a1 = cA + (size_t)(t + 1) * kstep;
            const char* a2 = last ? nA : cA + (size_t)(t + 2) * kstep; const char* b2 = last ? nB : cB + (size_t)(t + 2) * kstep;
            const char* a3 = a2 + kstep; const char* b3 = b2 + kstep;
            const unsigned hA2 = last ? nhA : chA, hB2 = last ? nhB : chB;
            if (act0) { PG8_LDB(B0, 0, 0); PG8_LDB(B1, 0, 1); PG8_SCHED; PG8_LDA(At, 0, 0); } if (stA_cur) PG8_STAGE(PG8_SA(1, 1), a1 + chA, voffA1);
            if (last && new_offs) MS_OFFS(nxt);
            MS_WAIT_K; PG8_WAIT_L(0); PG8_BAR; if (act0) { MS_MMA(0, 0, At, B0); MS_MMA(0, 1, At, B1); } PG8_BAR; PG8_SCHED;
            if (act1) PG8_LDA(At, 0, 1); PG8_STAGE(PG8_SB(0, 0), b2, voffB); PG8_STAGE(PG8_SB(0, 1), b2 + hB2, voffB); if (stA_nxt) PG8_STAGE(PG8_SA(0, 0), a2, voffA);
            MS_WAIT_K; PG8_WAIT_L(0); PG8_BAR; if (act1) { MS_MMA(1, 0, At, B0); MS_MMA(1, 1, At, B1); } PG8_BAR; PG8_SCHED;
            if (act0) { PG8_LDB(B0, 1, 0); PG8_LDB(B1, 1, 1); PG8_SCHED; PG8_LDA(At, 1, 0); } if (stA_nxt) PG8_STAGE(PG8_SA(0, 1), a2 + hA2, voffA1);
            MS_WAIT_K; PG8_WAIT_L(0); PG8_BAR; if (act0) { MS_MMA(0, 0, At, B0); MS_MMA(0, 1, At, B1); } PG8_BAR; PG8_SCHED;
            if (act1) PG8_LDA(At, 1, 1); PG8_STAGE(PG8_SB(1, 0), b3, voffB); PG8_STAGE(PG8_SB(1, 1), b3 + hB2, voffB); if (stA_nxt) PG8_STAGE(PG8_SA(1, 0), a3, voffA);
            MS_WAIT_K; PG8_WAIT_L(0); PG8_BAR; if (act1) { MS_MMA(1, 0, At, B0); MS_MMA(1, 1, At, B1); } PG8_BAR; PG8_SCHED;
        }
        if (wr == 0) PG8_BAR;
        if constexpr (KIND == 2) {
            const int ncols = S.order.nN * BM;
            const float* swp = S.swgu + cur.j * BM + wc * 32 + 8 * fq;
            f32x4 sw[2][2];
#pragma unroll
            for (int bj = 0; bj < 2; ++bj)
#pragma unroll
                for (int n = 0; n < 2; ++n) sw[bj][n] = *(const f32x4*)(swp + bj * HALF + 4 * n);
            const float* rsg = S.swd + cur.tile * BM + wr * 64 + fr;
            float rsv[2][4];
#pragma unroll
            for (int ai = 0; ai < 2; ++ai)
#pragma unroll
                for (int m = 0; m < 4; ++m) rsv[ai][m] = rsg[ai * HALF + m * 16];
            bf16_t* orow = S.hid + (size_t)(cur.tile * BM + wr * 64 + fr) * ncols + cur.j * BM + wc * 32 + 8 * fq;
#pragma unroll
            for (int ai = 0; ai < 2; ++ai)
#pragma unroll
                for (int m = 0; m < 4; ++m) { const float rs = rsv[ai][m];
#pragma unroll
                    for (int bj = 0; bj < 2; ++bj) { const i32x4 i0 = __builtin_bit_cast(i32x4, acc[ai][bj][m][0]), i1 = __builtin_bit_cast(i32x4, acc[ai][bj][m][1]); f32x4 v0, v1;
#pragma unroll
                        for (int e4 = 0; e4 < 4; ++e4) { v0[e4] = (float)i0[e4] * (rs * sw[bj][0][e4]); v1[e4] = (float)i1[e4] * (rs * sw[bj][1][e4]); }
                        *(u32x4*)(orow + (size_t)(ai * HALF + m * 16) * ncols + bj * HALF) = pack8(v0, v1); }
                    asm volatile("" ::: "memory"); }
        } else if constexpr (VAR >= 2) {
            if (VAR == 2) {
#pragma unroll
                for (int a_ = 0; a_ < 2; ++a_)
#pragma unroll
                    for (int b_ = 0; b_ < 2; ++b_)
#pragma unroll
                        for (int m_ = 0; m_ < 4; ++m_)
#pragma unroll
                            for (int n_ = 0; n_ < 2; ++n_) asm volatile("" :: "v"(acc[a_][b_][m_][n_])); }
        } else if constexpr (KIND == 0) {
            const PG8_LAS float* swp = S.lsc + cur.slot * 512 + cur.j * 256 + wc * 32 + 8 * fq;
            const f32x4 sg0 = *(const PG8_LAS f32x4*)swp, sg1 = *(const PG8_LAS f32x4*)(swp + 4), su0 = *(const PG8_LAS f32x4*)(swp + HALF), su1 = *(const PG8_LAS f32x4*)(swp + HALF + 4);
            asm volatile("" :: "v"(sg0), "v"(sg1), "v"(su0), "v"(su1));
            const PG8_LAS float* rsp = S.rscale + cur.slot * 256 + wr * 64 + fr;
            bf16_t* hrow = S.hid + (size_t)(cur.tile * BM + wr * 64 + fr) * 256 + 128 * cur.j + wc * 32 + 8 * fq;
#pragma unroll
            for (int ai = 0; ai < 2; ++ai)
#pragma unroll
                for (int m = 0; m < 4; ++m) { if (cur.rows <= ai * HALF + wr * 64 + m * 16) continue;
                    const float rs = rsp[ai * HALF + m * 16]; f32x4 h0, h1;
                    { const i32x4 gi = __builtin_bit_cast(i32x4, acc[ai][0][m][0]), ui = __builtin_bit_cast(i32x4, acc[ai][1][m][0]);
#pragma unroll
                        for (int e4 = 0; e4 < 4; ++e4) h0[e4] = silu_f((float)gi[e4] * (rs * sg0[e4])) * ((float)ui[e4] * (rs * su0[e4])); }
                    { const i32x4 gi = __builtin_bit_cast(i32x4, acc[ai][0][m][1]), ui = __builtin_bit_cast(i32x4, acc[ai][1][m][1]);
#pragma unroll
                        for (int e4 = 0; e4 < 4; ++e4) h1[e4] = silu_f((float)gi[e4] * (rs * sg1[e4])) * ((float)ui[e4] * (rs * su1[e4])); }
                    if (VAR == 0) *(u32x4*)(hrow + (size_t)(ai * HALF + m * 16) * 256) = pack8(h0, h1); else { u32x4 pk_ = pack8(h0, h1); asm volatile("" :: "v"(pk_)); } asm volatile("" ::: "memory"); }
        }
        else {
            const float swv = S.lsc[cur.slot * 8 + cur.j * 2 + (wc >> 1)];
            asm volatile("" :: "v"(swv));
            const PG8_LAS float* rsp = S.rscale + cur.slot * 256 + wr * 64 + fr;
            unsigned char* ycol = S.y + cur.j * BM + wc * 64 + 16 * fq; const PG8_LAS int* dsp = S.dst + cur.slot * 256 + wr * 64 + fr;
#pragma unroll
            for (int ai = 0; ai < 2; ++ai)
#pragma unroll
                for (int m = 0; m < 4; ++m) { if (cur.rows <= ai * HALF + wr * 64 + m * 16) continue;
                    const float rs = rsp[ai * HALF + m * 16] * swv; u32x4 w;
#pragma unroll
                    for (int bj = 0; bj < 2; ++bj)
#pragma unroll
                        for (int n = 0; n < 2; ++n) { const i32x4 vi = __builtin_bit_cast(i32x4, acc[ai][bj][m][n]);
                            typedef float f32x2_ __attribute__((ext_vector_type(2)));
                            const f32x2_ p0 = (f32x2_){(float)vi[0], (float)vi[1]} * (f32x2_){rs, rs}, p1 = (f32x2_){(float)vi[2], (float)vi[3]} * (f32x2_){rs, rs};
                            int t = __builtin_amdgcn_cvt_pk_fp8_f32(p0.x, p0.y, 0, false); t = __builtin_amdgcn_cvt_pk_fp8_f32(p1.x, p1.y, t, true); w[2 * bj + n] = (unsigned)t; }
                    const int d_ = dsp[ai * HALF + m * 16]; if (VAR == 0) { if (d_ >= 0) *(u32x4*)(ycol + (size_t)d_ * 1024) = w; } else asm volatile("" :: "v"(w), "v"(d_)); asm volatile("" ::: "memory"); }
        }
        if (!has_next) break;
#pragma unroll
        for (int a = 0; a < 2; ++a)
#pragma unroll
            for (int b = 0; b < 2; ++b)
#pragma unroll
                for (int m = 0; m < 4; ++m)
#pragma unroll
                    for (int n = 0; n < 2; ++n) acc[a][b][m][n] = (f32x4){0.f, 0.f, 0.f, 0.f};
        cur = nxt; cA = nA; cB = nB; chA = nhA; chB = nhB; nt = nnt; ++ui;
        if (wr == 1) PG8_BAR;
    }
    PG8_WAIT_V(0);
    PG8_BAR;
#undef MS_OFFS
#undef MS_WAIT_K
#undef MS_MMA
#undef PG8_MMA8
#undef MS_PARAMS
#undef PG8_SA
#undef PG8_SB
#undef PG8_STAGE
#undef PG8_LDA
#undef PG8_LDB
#undef PG8_MMA
#undef PG8_WAIT_V
#undef PG8_WAIT_L
#undef PG8_BAR
#undef PG8_SCHED
}


}

#ifndef MK_MULTI
#define MK_MULTI 0
#endif
constexpr int NWAVES = 8, NTHR = 512;
constexpr int D = 1024, NB = 8, SEQ = 4096, T = NB * SEQ;
constexpr int QC = 512, KVC = 128, CC = 512, INC = 1792;
constexpr int NE = 256, TOPK = 8, EH = 256, CW = 31;
constexpr int NEX = NE + 1;
constexpr int NSLOT = TOPK + 1;
constexpr int PMAX = T * TOPK + T + NEX * 256;
constexpr int MAXTILES = PMAX / 256;
constexpr float EPS = 1e-6f;
constexpr int NPHASE = 12;
constexpr size_t MiB = 1u << 20;
constexpr size_t WS_CTL = 0, CTL_ZERO_BYTES = 1 * MiB;
constexpr size_t WS_MOD = 1 * MiB;
constexpr size_t WS_ROWTOK = 2 * MiB, WS_ROWDST = WS_ROWTOK + (size_t)PMAX * 4, WS_ROWW = WS_ROWDST + (size_t)PMAX * 4;
constexpr size_t WS_EIDX = 6 * MiB, WS_GW = 7 * MiB, WS_POS = 8 * MiB;
constexpr size_t WS_WIN = 10 * MiB;
constexpr size_t WS_WOUT = 14 * MiB;
constexpr size_t WS_WRS = 16 * MiB;
constexpr size_t WS_XSLOTS = 18 * MiB;
constexpr size_t WS_WD = 20 * MiB;
constexpr size_t WS_LOGITS = 148 * MiB;
constexpr size_t WS_HIDSH = 180 * MiB;
constexpr size_t WS_HID = 148 * MiB;
constexpr size_t WS_H = 356 * MiB;
constexpr size_t WS_WGU = 420 * MiB;
constexpr size_t WS_H2Q = 549 * MiB;
constexpr size_t WS_SWGU = 2 * MiB;
constexpr size_t WS_SA = 3 * MiB;
constexpr size_t WS_WSHQ = 5 * MiB;
constexpr size_t WS_SWSH = 4 * MiB + 65536;
constexpr size_t WS_WINQ = 10 * MiB;
constexpr size_t WS_SWIN = 4 * MiB + 131072;
constexpr size_t WS_SA1 = 3 * MiB + 262144;
constexpr size_t WS_SWD = 4 * MiB;
constexpr size_t WS_HIDQ = 581 * MiB;
constexpr size_t WS_Y = 676 * MiB;
constexpr size_t WS_PROJ = 676 * MiB;
constexpr size_t WS_CAT = 788 * MiB;
constexpr size_t WS_LIST = 996 * MiB;
constexpr size_t WS_SLOT = 1012 * MiB;
constexpr size_t WS_END = 1020 * MiB;
static_assert(WS_HID + (size_t)PMAX * 512 <= WS_H && WS_LOGITS >= WS_WD + (size_t)NEX * 1024 * 256 && WS_H + (size_t)T * D * 2 <= WS_WGU && WS_WGU + (size_t)NEX * 512 * 1024 <= WS_H2Q && WS_H2Q + (size_t)T * D <= WS_HIDQ && WS_HIDQ + (size_t)PMAX * 256 <= WS_Y && WS_Y + (size_t)(T * NSLOT + 1) * 1024 <= WS_LIST && WS_LIST + (size_t)NE * T * 2 <= WS_SLOT && WS_SLOT + (size_t)NE * T <= WS_END && WS_PROJ + (size_t)T * INC * 2 <= WS_END, "d_ws map");
constexpr size_t WS_NEED = WS_END;
constexpr int CW_BAR = 4096;
constexpr int CW_COUNTS = 8192;
constexpr int CW_PANEL = 32768;
constexpr int CW_RFLAG = 2048;
constexpr int CW_SHQ = 1024;
constexpr int RING_BYTES = 131072;
constexpr int LX_MISC = 161792 - 256;
constexpr int LX_BASE = RING_BYTES + 256;
constexpr int LX_TEXP = LX_BASE + 1040;
constexpr int LX_CNT = LX_TEXP + 2880;
constexpr int LX_GL = LX_CNT + 1040;
constexpr int LX_RS = LX_GL + 6 * 512;
constexpr int LX_DST = LX_RS + 6 * 1024;
constexpr int LX_MY = LX_DST + 6 * 2048;
constexpr int LX_FT = LX_MY + 256;
constexpr int LX_CT = LX_FT + 2880;
constexpr int LDS_BYTES = 161792;
static_assert(LX_CT + 528 <= LDS_BYTES, "LDS map");

#define GAS __attribute__((address_space(1)))
#define LAS __attribute__((address_space(3)))
typedef unsigned short bf16;
typedef unsigned v4u __attribute__((ext_vector_type(4)));
typedef unsigned v2u __attribute__((ext_vector_type(2)));
typedef float f32x4 __attribute__((ext_vector_type(4)));
typedef float f32x16 __attribute__((ext_vector_type(16)));
typedef short bf16x8 __attribute__((ext_vector_type(8)));
typedef short s16x4 __attribute__((ext_vector_type(4)));
typedef GAS unsigned gu32;
#define RLX_AGENT __ATOMIC_RELAXED, __HIP_MEMORY_SCOPE_AGENT
using pg8::pkbf; using pg8::silu_f;
__device__ __forceinline__ float bf2f(unsigned short b) { return __uint_as_float((unsigned)b << 16); }
__device__ __forceinline__ float bflo(unsigned w) { return __uint_as_float(w << 16); }
__device__ __forceinline__ float bfhi(unsigned w) { return __uint_as_float(w & 0xffff0000u); }

#define XB_TMO      128
#define XB_XCNT(j)  (256  + 64 * (j))
#define XB_XSUB(j)  (1280 + 64 * (j))
#define XB_XGEN(j)  (2304 + 64 * (j))
#define XB_TOP      3328
#define XB_TOPGEN   3392
#define XCD_BAR_WORDS 3456
#define XB_SPIN_CAP (1u << 22)
__device__ __forceinline__ unsigned xb_ld(unsigned* p)              { return __hip_atomic_load(p, __ATOMIC_RELAXED, __HIP_MEMORY_SCOPE_AGENT); }
__device__ __forceinline__ unsigned xb_add(unsigned* p, unsigned v) { return __hip_atomic_fetch_add(p, v, __ATOMIC_RELAXED, __HIP_MEMORY_SCOPE_AGENT); }
__device__ __forceinline__ unsigned xb_xcc_id() { return (unsigned)__builtin_amdgcn_s_getreg((3 << 11) | 20) & 0xFu; }
#define XB_SPIN(cond, bar) do { unsigned _sp = 0; while (cond) { __builtin_amdgcn_s_sleep(1); \
    if ((++_sp & 255u) == 0u) { if (xb_ld(&(bar)[XB_TMO])) break; if (_sp > XB_SPIN_CAP) { atomicAdd(&(bar)[XB_TMO], 1u); break; } } } } while (0)
struct XcdBarrier { unsigned* bar; unsigned x; volatile LAS unsigned* st; };
__device__ __forceinline__ XcdBarrier xcd_barrier_post(unsigned* bar, volatile LAS unsigned* st) {
    XcdBarrier b; b.bar = bar; b.x = xb_xcc_id(); b.st = st;
    if (threadIdx.x == 0) st[2] = xb_add(&bar[XB_XCNT(b.x)], 1u);
    return b;
}
__device__ __forceinline__ void xcd_barrier_complete(unsigned* bar, unsigned x, unsigned& nloc, unsigned& nx, unsigned& even) {
    const unsigned G = gridDim.x * gridDim.y * gridDim.z;
    unsigned sum, cnt, mine, sp = 0u, lowok;
    for (;;) {
        sum = 0u; cnt = 0u; mine = 0u; lowok = 1u;
#pragma unroll
        for (unsigned j = 0; j < 16; ++j) { const unsigned c = xb_ld(&bar[XB_XCNT(j)]); sum += c; cnt += (c > 0u) ? 1u : 0u; mine = (j == x) ? c : mine; lowok &= (j < 8u ? (c * 8u == G) : (c == 0u)) ? 1u : 0u; }
        if (sum == G) break;
        __builtin_amdgcn_s_sleep(1);
        if ((++sp & 255u) == 0u) { if (xb_ld(&bar[XB_TMO])) break; if (sp > XB_SPIN_CAP) { atomicAdd(&bar[XB_TMO], 1u); break; } }
    }
    nloc = mine > 0u ? mine : 1u; nx = cnt > 0u ? cnt : 1u; even = lowok;
}
__device__ __forceinline__ void xcd_barrier(const XcdBarrier& b) {
    asm volatile("s_waitcnt vmcnt(0)" ::: "memory");
    __syncthreads();
    if (threadIdx.x == 0) {
        unsigned* bar = b.bar;
        __builtin_amdgcn_s_waitcnt(0);
        unsigned nloc = b.st[0], nx = b.st[1];
        if (nloc == 0u) { unsigned even; xcd_barrier_complete(bar, b.x, nloc, nx, even); b.st[0] = nloc; b.st[1] = nx; b.st[3] = even; }
        const unsigned old = xb_add(&bar[XB_XSUB(b.x)], 1u);
        const unsigned gen = old / nloc;
        if (old + 1u == (gen + 1u) * nloc) {
            asm volatile("buffer_wbl2 sc1\n\tbuffer_inv sc1\n\ts_waitcnt vmcnt(0)" ::: "memory");
            const unsigned og = xb_add(&bar[XB_TOP], 1u);
            const unsigned tg = og / nx;
            if (og + 1u == (tg + 1u) * nx) xb_add(&bar[XB_TOPGEN], 1u);
            else XB_SPIN(xb_ld(&bar[XB_TOPGEN]) == tg, bar);
            xb_add(&bar[XB_XGEN(b.x)], 1u);
            asm volatile("s_waitcnt vmcnt(0)" ::: "memory");
        } else {
            asm volatile("buffer_inv sc1" ::: "memory");
            XB_SPIN(xb_ld(&bar[XB_XGEN(b.x)]) == gen, bar);
            asm volatile("s_waitcnt vmcnt(0)" ::: "memory");
        }
    }
    __syncthreads();
}

__device__ __forceinline__ void xcd_local_barrier(const XcdBarrier& b) {
    asm volatile("s_waitcnt vmcnt(0)" ::: "memory");
    __syncthreads();
    if (threadIdx.x == 0) {
        unsigned* bar = b.bar;
        __builtin_amdgcn_s_waitcnt(0);
        const unsigned nloc = b.st[0];
        const unsigned old = xb_add(&bar[XB_XSUB(b.x)], 1u);
        const unsigned gen = old / nloc;
        asm volatile("buffer_inv sc1" ::: "memory");
        if (old + 1u == (gen + 1u) * nloc) xb_add(&bar[XB_XGEN(b.x)], 1u);
        else XB_SPIN(xb_ld(&bar[XB_XGEN(b.x)]) == gen, bar);
        asm volatile("s_waitcnt vmcnt(0)" ::: "memory");
    }
    __syncthreads();
}

#define LDS_WAIT() asm volatile("s_waitcnt lgkmcnt(0)" ::: "memory")
__device__ __forceinline__ float wave_sum(float v) {
#pragma unroll
    for (int o = 1; o < 64; o <<= 1) v += __shfl_xor(v, o);
    return v;
}

__device__ __forceinline__ float wave_max_f(float x) {
    int v = (int)__float_as_uint(x);
#define WMX_STEP(ctrl, rmask) { const int o = __builtin_amdgcn_update_dpp(v, v, ctrl, rmask, 0xf, false); v = (int)__float_as_uint(fmaxf(__uint_as_float((unsigned)v), __uint_as_float((unsigned)o))); }
    WMX_STEP(0xb1, 0xf)
    WMX_STEP(0x4e, 0xf)
    WMX_STEP(0x114, 0xf)
    WMX_STEP(0x118, 0xf)
    WMX_STEP(0x142, 0xa)
    WMX_STEP(0x143, 0xc)
#undef WMX_STEP
    return __uint_as_float((unsigned)__builtin_amdgcn_readlane(v, 63));
}
__device__ __forceinline__ float wave_sum_dpp(float x) {
    int v = (int)__float_as_uint(x);
#define WSM_STEP(ctrl, rmask) { const int o = __builtin_amdgcn_update_dpp(0, v, ctrl, rmask, 0xf, false); v = (int)__float_as_uint(__uint_as_float((unsigned)v) + __uint_as_float((unsigned)o)); }
    WSM_STEP(0xb1, 0xf)
    WSM_STEP(0x4e, 0xf)
    WSM_STEP(0x114, 0xf)
    WSM_STEP(0x118, 0xf)
    WSM_STEP(0x142, 0xa)
    WSM_STEP(0x143, 0xc)
#undef WSM_STEP
    return __uint_as_float((unsigned)__builtin_amdgcn_readlane(v, 63));
}
__device__ __forceinline__ float dpp16_sum(float x) {
    int v = (int)__float_as_uint(x);
#define D8_STEP(ctrl) { const int o = __builtin_amdgcn_update_dpp(v, v, ctrl, 0xf, 0xf, false); v = (int)__float_as_uint(__uint_as_float((unsigned)v) + __uint_as_float((unsigned)o)); }
    D8_STEP(0xb1) D8_STEP(0x4e) D8_STEP(0x141) D8_STEP(0x140)
#undef D8_STEP
    return __uint_as_float((unsigned)v);
}
struct Args { const float* in[22]; float* out; unsigned char* ws; int ph_lo, ph_hi, aux, pad; };
__device__ __forceinline__ const float* inp(int i) {
    typedef const float* cfp;
    const __attribute__((address_space(4))) cfp* ka = (const __attribute__((address_space(4))) cfp*)__builtin_amdgcn_kernarg_segment_ptr();
    return *(const volatile __attribute__((address_space(4))) cfp*)(ka + i);
}

__device__ __forceinline__ void transpose_tile_p(const float* src, int ldsrc, bf16* dst, int ldd, const int (&ro)[4], LAS float* scr, int lane) {
    float tv[32];
#pragma unroll
    for (int i = 0; i < 32; ++i) tv[i] = __builtin_nontemporal_load(src + (size_t)(2 * i + (lane >> 5)) * ldsrc + (lane & 31));
#pragma unroll
    for (int i = 0; i < 32; ++i) scr[(2 * i + (lane >> 5)) * 33 + (lane & 31)] = tv[i];
    LDS_WAIT(); asm volatile("" ::: "memory");
    const int c = lane & 7;
#pragma unroll
    for (int j = 0; j < 4; ++j) { const int n = (lane >> 3) + 8 * j; const LAS float* s = scr + (8 * c) * 33 + n;
        v4u o; o.x = pkbf(s[0 * 33], s[1 * 33]); o.y = pkbf(s[2 * 33], s[3 * 33]); o.z = pkbf(s[4 * 33], s[5 * 33]); o.w = pkbf(s[6 * 33], s[7 * 33]);
        *(GAS v4u*)(dst + (size_t)(ro[j] + (lane >> 3)) * ldd + 8 * c) = o; }
    LDS_WAIT(); asm volatile("" ::: "memory");
}
__device__ __forceinline__ void transpose_tile(const float* src, int ldsrc, bf16* dst, int ldd, LAS float* scr, int lane) {
    float tv[32];
#pragma unroll
    for (int i = 0; i < 32; ++i) tv[i] = __builtin_nontemporal_load(src + (size_t)(2 * i + (lane >> 5)) * ldsrc + (lane & 31));
#pragma unroll
    for (int i = 0; i < 32; ++i) scr[(2 * i + (lane >> 5)) * 33 + (lane & 31)] = tv[i];
    LDS_WAIT(); asm volatile("" ::: "memory");
    const int c = lane & 7;
#pragma unroll
    for (int j = 0; j < 4; ++j) { const int n = (lane >> 3) + 8 * j; const LAS float* s = scr + (8 * c) * 33 + n;
        v4u o; o.x = pkbf(s[0 * 33], s[1 * 33]); o.y = pkbf(s[2 * 33], s[3 * 33]); o.z = pkbf(s[4 * 33], s[5 * 33]); o.w = pkbf(s[6 * 33], s[7 * 33]);
        *(GAS v4u*)(dst + (size_t)n * ldd + 8 * c) = o; }
    LDS_WAIT(); asm volatile("" ::: "memory");
}
__device__ __forceinline__ void p0_phase(const Args& a, LAS unsigned char* lds, int tid, int lane, int wave, int G) {
    unsigned char* ws = a.ws;
    if ((int)blockIdx.x < 192) {
        LAS float* sc = (LAS float*)lds;
        LAS float* red = (LAS float*)(lds + 32768);
        const float* c = inp(1);
        for (int i = tid; i < 8192; i += NTHR) sc[i] = silu_f(c[i]);
        __syncthreads();
        const int cl = tid & 31, ks = tid >> 5, col = blockIdx.x * 32 + cl;
        const float* w = inp(2) + (size_t)(ks * 64) * 6144 + col;
        float acc[8];
#pragma unroll
        for (int b = 0; b < 8; ++b) acc[b] = 0.f;
#pragma unroll 8
        for (int k = 0; k < 64; ++k) { const float wv = w[(size_t)k * 6144];
#pragma unroll
            for (int b = 0; b < 8; ++b) acc[b] += sc[b * 1024 + ks * 64 + k] * wv; }
#pragma unroll
        for (int b = 0; b < 8; ++b) red[(ks * 8 + b) * 32 + cl] = acc[b];
        __syncthreads();
        if (tid < 256) { const int b = tid >> 5; float s = 0.f;
#pragma unroll
            for (int k2 = 0; k2 < 16; ++k2) s += red[(k2 * 8 + b) * 32 + cl];
            __hip_atomic_store((float*)(ws + WS_MOD) + b * 6144 + col, s + inp(3)[col], __ATOMIC_RELAXED, __HIP_MEMORY_SCOPE_AGENT); }
        asm volatile("s_waitcnt vmcnt(0)" ::: "memory");
        __syncthreads();
        if (tid == 0) __hip_atomic_fetch_add((unsigned*)(ws + WS_CTL) + CW_SHQ, 1u, __ATOMIC_RELAXED, __HIP_MEMORY_SCOPE_AGENT);
    }
    {
        LAS float* blk = (LAS float*)lds;
        LAS float* pm = (LAS float*)(lds + LX_TEXP);
        LAS float* inv = (LAS float*)(lds + LX_CNT);
        const int n = tid & 31, ks = tid >> 5;
        float tv[64];
        int it = blockIdx.x;
        constexpr int NB1 = (NE + 1) * 16 + INC / 32;
#define B1_DESC(item, SRC, LD, DST, SCL) do { if ((item) < (NE + 1) * 16) { const int e_ = (item) >> 4, up_ = ((item) >> 3) & 1, n0_ = 32 * ((item) & 7); const int dr_ = 256 * (n0_ >> 7) + 128 * up_ + (n0_ & 127); \
                LD = 256; if (e_ < NE) { SRC = inp(15 + up_) + (size_t)e_ * 1024 * 256 + n0_; DST = ws + WS_WGU + (size_t)(e_ * 512 + dr_) * 1024; SCL = (float*)(ws + WS_SWGU) + e_ * 512 + dr_; } \
                else { SRC = inp(18 + up_) + n0_; DST = ws + WS_WGU + (size_t)(NE * 512 + dr_) * 1024; SCL = (float*)(ws + WS_SWGU) + NE * 512 + dr_; } } \
            else { const int n0_ = 32 * ((item) - (NE + 1) * 16); LD = INC; SRC = inp(4) + n0_; DST = ws + WS_WINQ + (size_t)n0_ * 1024; SCL = (float*)(ws + WS_SWIN) + n0_; } } while (0)
#define B1_LOAD(item) do { const float* s0_; int ld_; unsigned char* d0_; float* c0_; B1_DESC(item, s0_, ld_, d0_, c0_); (void)d0_; (void)c0_; const float* sp_ = s0_ + (size_t)(ks * 64) * ld_ + n; \
            _Pragma("unroll") for (int k = 0; k < 64; ++k) tv[k] = __builtin_nontemporal_load(sp_ + (size_t)k * ld_); } while (0)
        if (it < NB1) B1_LOAD(it);
        for (; it < NB1; it += G) {
            const float* src0; int ld0; unsigned char* dst0; float* scl0; B1_DESC(it, src0, ld0, dst0, scl0); (void)src0; (void)ld0;
            float mxv = 0.f;
#pragma unroll
            for (int k = 0; k < 64; ++k) { mxv = fmaxf(mxv, fabsf(tv[k])); blk[(ks * 64 + k) * 32 + n] = tv[k]; }
            pm[ks * 32 + n] = mxv;
            __syncthreads();
            if (it + G < NB1) B1_LOAD(it + G);
            if (tid < 32) { float mx2 = 0.f;
#pragma unroll
                for (int k2 = 0; k2 < 16; ++k2) mx2 = fmaxf(mx2, pm[k2 * 32 + tid]);
                const float sc = mx2 > 0.f ? mx2 * (1.0f / 127.0f) : 1.0f; inv[tid] = 1.0f / sc; scl0[tid] = sc; }
            __syncthreads();
            const float iv = inv[n];
#pragma unroll
            for (int c2 = 0; c2 < 2; ++c2) { const int kc = ks + 16 * c2; const LAS float* s = blk + (32 * kc) * 32 + n;
                unsigned q[8];
#pragma unroll
                for (int w4 = 0; w4 < 8; ++w4) { unsigned pk = 0u;
#pragma unroll
                    for (int b = 0; b < 4; ++b) { int qi = (int)rintf(s[(4 * w4 + b) * 32] * iv); qi = qi > 127 ? 127 : (qi < -127 ? -127 : qi); pk |= ((unsigned)qi & 0xffu) << (8 * b); }
                    q[w4] = pk; }
                unsigned char* dp = dst0 + (size_t)n * 1024 + 32 * kc;
                *(GAS v4u*)dp = (v4u){q[0], q[1], q[2], q[3]}; *(GAS v4u*)(dp + 16) = (v4u){q[4], q[5], q[6], q[7]}; }
            __syncthreads();
        }
#undef B1_LOAD
#undef B1_DESC
        LAS float* pm2 = pm;
        LAS float* inv2 = (LAS float*)(lds + LX_GL);
        const int n2 = tid & 127, ks2 = tid >> 7;
        it = (int)((blockIdx.x + (unsigned)G - (unsigned)(NB1 % G)) % (unsigned)G);
#define B2_LOAD(item) do { const int e_ = (item) >> 3, n0_ = 128 * ((item) & 7); const float* sp_ = (e_ < NE ? inp(17) + (size_t)e_ * 256 * 1024 : inp(20)) + (size_t)(ks2 * 64) * 1024 + n0_ + n2; \
            _Pragma("unroll") for (int k = 0; k < 64; ++k) tv[k] = __builtin_nontemporal_load(sp_ + (size_t)k * 1024); } while (0)
        if (it < NEX * 8) B2_LOAD(it);
        for (; it < NEX * 8; it += G) {
            const int e = it >> 3, n0 = 128 * (it & 7);
            const int cg = n0 + n2, c2 = cg & 255; const int drow = e * 1024 + (cg & ~255) + 128 * ((c2 >> 3) & 1) + 32 * (c2 >> 6) + 8 * ((c2 >> 4) & 3) + (c2 & 7);
            float mxv = 0.f;
#pragma unroll
            for (int k = 0; k < 64; ++k) { mxv = fmaxf(mxv, fabsf(tv[k])); blk[(ks2 * 64 + k) * 128 + n2] = tv[k]; }
            pm2[ks2 * 128 + n2] = mxv;
            __syncthreads();
            if (it + G < NEX * 8) B2_LOAD(it + G);
            if (tid < 64) { float mx2 = 0.f;
#pragma unroll
                for (int i8 = 0; i8 < 8; ++i8) mx2 = fmaxf(mx2, pm2[tid + 64 * i8]);
                mx2 = wave_max_f(mx2);
                const float sc = mx2 > 0.f ? mx2 * (1.0f / 127.0f) : 1.0f; if (tid == 0) { inv2[0] = 1.0f / sc; ((float*)(ws + WS_SWD))[it] = sc; } }
            __syncthreads();
            const float iv = inv2[0];
#pragma unroll
            for (int c3 = 0; c3 < 2; ++c3) { const int kc = ks2 + 4 * c3; const LAS float* s = blk + (32 * kc) * 128 + n2;
                unsigned q[8];
#pragma unroll
                for (int w4 = 0; w4 < 8; ++w4) { unsigned pk = 0u;
#pragma unroll
                    for (int b = 0; b < 4; ++b) { int qi = (int)rintf(s[(4 * w4 + b) * 128] * iv); qi = qi > 127 ? 127 : (qi < -127 ? -127 : qi); pk |= ((unsigned)qi & 0xffu) << (8 * b); }
                    q[w4] = pk; }
                unsigned char* dp = ws + WS_WD + (size_t)drow * 256 + 32 * kc;
                *(GAS v4u*)dp = (v4u){q[0], q[1], q[2], q[3]}; *(GAS v4u*)(dp + 16) = (v4u){q[4], q[5], q[6], q[7]}; }
            __syncthreads();
        }
#undef B2_LOAD
    }
    LAS float* scr = (LAS float*)(lds + wave * 16384);
    const int gw = blockIdx.x * NWAVES + wave, NGW = G * NWAVES;
    constexpr int I_IN = 16 * 56, I_OUT = 16 * 32, I_R = 16 * 8, I_SD = 4 * 32, I_E = 128;
    constexpr int NSMALL = I_OUT + I_R;
    constexpr int NITEMS = NSMALL;
    for (int it = gw; it < NITEMS; it += NGW) {
        int r = it;
        if (r < NSMALL) {
            if (r < I_OUT) { const int kb = r / 32, nb = r % 32; transpose_tile(inp(12) + (size_t)(64 * kb) * 1024 + 32 * nb, 1024, (bf16*)(ws + WS_WOUT) + (size_t)(32 * nb) * 1024 + 64 * kb, 1024, scr, lane); continue; } r -= I_OUT;
            if (r < I_R) { const int kb = r / 8, nb = r % 8; transpose_tile(inp(13) + (size_t)(64 * kb) * 256 + 32 * nb, 256, (bf16*)(ws + WS_WRS) + (size_t)(32 * nb) * 1024 + 64 * kb, 1024, scr, lane); continue; } r -= I_R;
        }
    }
}

__device__ __forceinline__ void norm_phase(const float* src, bf16* dst, const float* mod, int shoff, int lane, int wave, int G) {
    const int gw = blockIdx.x * NWAVES + wave, NGW = G * NWAVES;
    for (int m = gw; m < T; m += NGW) {
        const GAS f32x4* xr = (const GAS f32x4*)(src + (size_t)m * D) + lane;
        const float* mb = mod + (size_t)(m >> 12) * 6144 + shoff;
        f32x4 v[4]; float s = 0.f;
#pragma unroll
        for (int j = 0; j < 4; ++j) { v[j] = xr[64 * j]; s += (v[j].x * v[j].x + v[j].y * v[j].y) + (v[j].z * v[j].z + v[j].w * v[j].w); }
        const float r = 1.0f / sqrtf(wave_sum(s) * (1.f / D) + EPS);
        GAS v2u* o8 = (GAS v2u*)(dst + (size_t)m * D) + lane;
#pragma unroll
        for (int j = 0; j < 4; ++j) { const f32x4 sh = *(const f32x4*)(mb + 4 * lane + 256 * j), sc = *(const f32x4*)(mb + 1024 + 4 * lane + 256 * j);
            const f32x4 y = v[j] * r * (sc + 1.0f) + sh; v2u o; o.x = pkbf(y.x, y.y); o.y = pkbf(y.z, y.w); o8[64 * j] = o; }
    }
}

__device__ __forceinline__ void quant_phase(const bf16* src, unsigned char* dst, float* scales, int lane, int wave, int G) {
    const int gw = blockIdx.x * NWAVES + wave, NGW = G * NWAVES;
    for (int t = gw; t < T; t += NGW) {
        const GAS v4u* sp = (const GAS v4u*)(src + (size_t)t * D + 16 * lane);
        const v4u a0 = sp[0], a1 = sp[1];
        float v[16];
        v[0] = bflo(a0.x); v[1] = bfhi(a0.x); v[2] = bflo(a0.y); v[3] = bfhi(a0.y); v[4] = bflo(a0.z); v[5] = bfhi(a0.z); v[6] = bflo(a0.w); v[7] = bfhi(a0.w);
        v[8] = bflo(a1.x); v[9] = bfhi(a1.x); v[10] = bflo(a1.y); v[11] = bfhi(a1.y); v[12] = bflo(a1.z); v[13] = bfhi(a1.z); v[14] = bflo(a1.w); v[15] = bfhi(a1.w);
        float mxv = 0.f;
#pragma unroll
        for (int i = 0; i < 16; ++i) mxv = fmaxf(mxv, fabsf(v[i]));
        mxv = wave_max_f(mxv);
        const float sc = mxv > 0.f ? mxv * (1.0f / 127.0f) : 1.0f, iv = 1.0f / sc;
        unsigned q[4];
#pragma unroll
        for (int w4 = 0; w4 < 4; ++w4) { unsigned pk = 0u;
#pragma unroll
            for (int b = 0; b < 4; ++b) { int qi = (int)rintf(v[4 * w4 + b] * iv); qi = qi > 127 ? 127 : (qi < -127 ? -127 : qi); pk |= ((unsigned)qi & 0xffu) << (8 * b); }
            q[w4] = pk; }
        *(GAS v4u*)(dst + (size_t)t * D + 16 * lane) = (v4u){q[0], q[1], q[2], q[3]};
        if (lane == 0) scales[t] = sc;
    }
}

__device__ __forceinline__ void norm_quant_phase(const float* src, unsigned char* dst, float* scales, const float* mod, int lane, int wave, int G) {
    const int gw = blockIdx.x * NWAVES + wave, NGW = G * NWAVES;
    for (int m = gw; m < T; m += NGW) {
        const GAS f32x4* xr = (const GAS f32x4*)(src + (size_t)m * D + 16 * lane);
        const float* mb = mod + (size_t)(m >> 12) * 6144 + 16 * lane;
        f32x4 v[4]; float s = 0.f;
#pragma unroll
        for (int j = 0; j < 4; ++j) { v[j] = xr[j]; s += (v[j].x * v[j].x + v[j].y * v[j].y) + (v[j].z * v[j].z + v[j].w * v[j].w); }
        const float r = 1.0f / sqrtf(wave_sum_dpp(s) * (1.f / D) + EPS);
        float mxv = 0.f;
#pragma unroll
        for (int j = 0; j < 4; ++j) { const f32x4 sh = *(const f32x4*)(mb + 4 * j), sc = *(const f32x4*)(mb + 1024 + 4 * j);
            v[j] = v[j] * r * (sc + 1.0f) + sh; mxv = fmaxf(mxv, fmaxf(fmaxf(fabsf(v[j].x), fabsf(v[j].y)), fmaxf(fabsf(v[j].z), fabsf(v[j].w)))); }
        mxv = wave_max_f(mxv);
        const float qs = mxv > 0.f ? mxv * (1.0f / 127.0f) : 1.0f, iv = 1.0f / qs;
        unsigned q[4];
#pragma unroll
        for (int j = 0; j < 4; ++j) { unsigned pk = 0u;
#pragma unroll
            for (int b = 0; b < 4; ++b) { int qi = (int)rintf(v[j][b] * iv); qi = qi > 127 ? 127 : (qi < -127 ? -127 : qi); pk |= ((unsigned)qi & 0xffu) << (8 * b); }
            q[j] = pk; }
        *(GAS v4u*)(dst + (size_t)m * D + 16 * lane) = (v4u){q[0], q[1], q[2], q[3]};
        if (lane == 0) scales[m] = qs;
    }
}
__device__ __forceinline__ void quant_rows(const bf16* src, unsigned char* dst, float* scales, LAS float* rs, int row0, int lane, int wave) {
    for (int r = wave; r < 256; r += NWAVES) { const int t = row0 + r;
        const GAS v4u* sp = (const GAS v4u*)(src + (size_t)t * D + 16 * lane);
        const v4u a0 = sp[0], a1 = sp[1];
        float v[16];
        v[0] = bflo(a0.x); v[1] = bfhi(a0.x); v[2] = bflo(a0.y); v[3] = bfhi(a0.y); v[4] = bflo(a0.z); v[5] = bfhi(a0.z); v[6] = bflo(a0.w); v[7] = bfhi(a0.w);
        v[8] = bflo(a1.x); v[9] = bfhi(a1.x); v[10] = bflo(a1.y); v[11] = bfhi(a1.y); v[12] = bflo(a1.z); v[13] = bfhi(a1.z); v[14] = bflo(a1.w); v[15] = bfhi(a1.w);
        float mxv = 0.f;
#pragma unroll
        for (int i = 0; i < 16; ++i) mxv = fmaxf(mxv, fabsf(v[i]));
        mxv = wave_max_f(mxv);
        const float sc = mxv > 0.f ? mxv * (1.0f / 127.0f) : 1.0f, iv = 1.0f / sc;
        unsigned q[4];
#pragma unroll
        for (int w4 = 0; w4 < 4; ++w4) { unsigned pk = 0u;
#pragma unroll
            for (int b = 0; b < 4; ++b) { int qi = (int)rintf(v[4 * w4 + b] * iv); qi = qi > 127 ? 127 : (qi < -127 ? -127 : qi); pk |= ((unsigned)qi & 0xffu) << (8 * b); }
            q[w4] = pk; }
        *(GAS v4u*)(dst + (size_t)t * D + 16 * lane) = (v4u){q[0], q[1], q[2], q[3]};
        if (lane == 0) { scales[t] = sc; rs[r] = sc; }
    }
}

constexpr int VT_LD = 260;
constexpr int BD_LD = 192;
constexpr int AL_VT = 0, AL_BIAS = 2 * 64 * VT_LD * 2  , AL_SS = AL_BIAS + 8 * BD_LD * 4, AL_GAIN = AL_SS + 2 * 8 * 32 * 4, AL_END = AL_GAIN + 512 * 4, AL_KI = AL_END  , AL_END2 = AL_KI + 65536;
constexpr int CL_U = 0, CL_C = 31 * 512 * 4  ;
static_assert(AL_END <= RING_BYTES && AL_END2 <= LX_MISC && 2 * CL_C + 4096 <= RING_BYTES, "P3 LDS");
#define MFMA32(a, b, c) __builtin_amdgcn_mfma_f32_32x32x16_bf16((a), (b), (c), 0, 0, 0)
#define LDS_BAR() do { asm volatile("s_waitcnt lgkmcnt(0)" ::: "memory"); __builtin_amdgcn_s_barrier(); asm volatile("" ::: "memory"); } while (0)
__device__ __forceinline__ void p3_unit(const Args& a, LAS unsigned char* lds, int unit, int tid, int lane, int wave) {
    unsigned char* ws = a.ws;
    const bf16* proj = (const bf16*)(ws + WS_PROJ);
    bf16* cat = (bf16*)(ws + WS_CAT);
    const int b = unit >> 5, qb = unit & 31, t0 = b * SEQ + qb * 128;
#ifndef REP_ATT
#define REP_ATT 1
#endif
#ifndef REP_CONV
#define REP_CONV 1
#endif
#pragma nounroll
    for (int ra_ = 0; ra_ < REP_ATT; ++ra_)
    {
        LAS bf16* vt = (LAS bf16*)(lds + AL_VT);
        LAS float* biasd = (LAS float*)(lds + AL_BIAS);
        LAS float* ssb = (LAS float*)(lds + AL_SS);
#pragma unroll
        for (int i = 0; i < 4; ++i) { const int p = tid + NTHR * i, kp = p & 127, c16 = p >> 7, ki = 2 * kp; const int tk = (qb == 0 && ki < 128) ? t0 + ki : t0 - 128 + ki;
            const v4u v0 = *(const GAS v4u*)(proj + (size_t)tk * INC + 640 + 8 * c16), v1 = *(const GAS v4u*)(proj + (size_t)(tk + 1) * INC + 640 + 8 * c16);
            LAS unsigned* d = (LAS unsigned*)(vt + (size_t)(8 * c16) * VT_LD + ki);
            d[0 * (VT_LD / 2)] = (v0.x & 0xffffu) | (v1.x << 16); d[1 * (VT_LD / 2)] = (v0.x >> 16) | (v1.x & 0xffff0000u);
            d[2 * (VT_LD / 2)] = (v0.y & 0xffffu) | (v1.y << 16); d[3 * (VT_LD / 2)] = (v0.y >> 16) | (v1.y & 0xffff0000u);
            d[4 * (VT_LD / 2)] = (v0.z & 0xffffu) | (v1.z << 16); d[5 * (VT_LD / 2)] = (v0.z >> 16) | (v1.z & 0xffff0000u);
            d[6 * (VT_LD / 2)] = (v0.w & 0xffffu) | (v1.w << 16); d[7 * (VT_LD / 2)] = (v0.w >> 16) | (v1.w & 0xffff0000u); }
        { LAS unsigned char* kimg = lds + AL_KI;
#pragma unroll
            for (int i = 0; i < 8; ++i) { const int p = tid + NTHR * i, ki = p >> 4, c16 = p & 15; const int tk = (qb == 0 && ki < 128) ? t0 + ki : t0 - 128 + ki;
                *(LAS v4u*)(kimg + ki * 256 + ((c16 ^ (ki & 15)) << 4)) = *(const GAS v4u*)(proj + (size_t)tk * INC + 512 + 8 * c16); } }
        for (int i = tid; i < 8 * BD_LD; i += NTHR) { const int hh = i / BD_LD, n = i % BD_LD - 32; float bv = 0.f;
            if (n >= 0 && n < 128) { int bk = n; if (n >= 16) { bk = 16 + (int)(log2f((float)n * (1.0f / 16.0f)) * (16.0f / 3.0f)); bk = bk > 31 ? 31 : bk; }
                bv = inp(6)[bk * 8 + hh] * 1.44269504f; }
            biasd[i] = bv; }
        LAS float* gain = (LAS float*)(lds + AL_GAIN);
        gain[tid] = inp(7)[tid];
        __syncthreads();
        const int h = wave, kvh = h >> 2, hh = lane >> 5;
        const float sink2 = inp(5)[h] * 1.44269504f;
        for (int i = 0; i < 4; ++i) {
            int r = lane & 31; asm volatile("" : "+v"(r));
            const int tq = t0 + 32 * i + r;
            bf16x8 qf[4];
#pragma unroll
            for (int s = 0; s < 4; ++s) qf[s] = *(const GAS bf16x8*)(proj + (size_t)tq * INC + h * 64 + 16 * s + 8 * hh);
            f32x16 sc[5];
#pragma unroll
            for (int kb = 0; kb < 5; ++kb) {
                const int ki = 32 * (i + kb) + r; const LAS unsigned char* kr = lds + AL_KI + ki * 256;
                bf16x8 kf[4];
#pragma unroll
                for (int s = 0; s < 4; ++s) kf[s] = *(const LAS bf16x8*)(kr + (((kvh * 8 + 2 * s + hh) ^ (ki & 15)) << 4));
                f32x16 acc;
#pragma unroll
                for (int e = 0; e < 16; ++e) acc[e] = 0.f;
#pragma unroll
                for (int s = 0; s < 4; ++s) acc = MFMA32(kf[s], qf[s], acc);
                sc[kb] = acc;
            }
            const LAS float* bdr = biasd + h * BD_LD + 32 + 128 + r - 4 * hh;
            float mx = sink2;
#pragma unroll
            for (int kb = 0; kb < 5; ++kb) {
                const bool tile_ok = qb > 0 || (i + kb) >= 4;
#pragma unroll
                for (int e = 0; e < 16; ++e) { const int kk0 = (e & 3) + 8 * (e >> 2); const int kk = kk0 + 4 * hh;
                    bool ok = tile_ok; if (kb == 0) ok = ok && (kk > r); if (kb == 4) ok = ok && (kk <= r);
                    const float bv = bdr[-32 * kb - kk0];
                    const float lv = sc[kb][e] * (0.125f * 1.44269504f) + bv; const float lg = ok ? lv : -INFINITY; sc[kb][e] = lg; mx = fmaxf(mx, lg); } }
            mx = fmaxf(mx, __shfl_xor(mx, 32));
            float sum = 0.f;
#pragma unroll
            for (int kb = 0; kb < 5; ++kb)
#pragma unroll
                for (int e = 0; e < 16; ++e) { const float p = __builtin_amdgcn_exp2f(sc[kb][e] - mx); sc[kb][e] = p; sum += p; }
            sum += __shfl_xor(sum, 32);
            const float inv = 1.0f / (sum + __builtin_amdgcn_exp2f(sink2 - mx));
            f32x16 o0, o1;
#pragma unroll
            for (int e = 0; e < 16; ++e) { o0[e] = 0.f; o1[e] = 0.f; }
#pragma unroll
            for (int kb = 0; kb < 5; ++kb)
#pragma unroll
                for (int s = 0; s < 2; ++s) {
                    v4u pw; pw.x = pkbf(sc[kb][8 * s + 0], sc[kb][8 * s + 1]); pw.y = pkbf(sc[kb][8 * s + 2], sc[kb][8 * s + 3]); pw.z = pkbf(sc[kb][8 * s + 4], sc[kb][8 * s + 5]); pw.w = pkbf(sc[kb][8 * s + 6], sc[kb][8 * s + 7]);
                    const bf16x8 pf = __builtin_bit_cast(bf16x8, pw);
                    const int kcol = 32 * (i + kb) + 16 * s + 4 * hh;
                    const LAS bf16* v0 = vt + (size_t)(kvh * 64 + r) * VT_LD + kcol;
                    const s16x4 a0 = *(const LAS s16x4*)v0, a1 = *(const LAS s16x4*)(v0 + 8);
                    const s16x4 c0 = *(const LAS s16x4*)(v0 + 32 * VT_LD), c1 = *(const LAS s16x4*)(v0 + 32 * VT_LD + 8);
                    o0 = MFMA32(__builtin_shufflevector(a0, a1, 0, 1, 2, 3, 4, 5, 6, 7), pf, o0);
                    o1 = MFMA32(__builtin_shufflevector(c0, c1, 0, 1, 2, 3, 4, 5, 6, 7), pf, o1);
                }
            float ss = 0.f;
#pragma unroll
            for (int e = 0; e < 16; ++e) { o0[e] *= inv; o1[e] *= inv; ss += o0[e] * o0[e] + o1[e] * o1[e]; }
            ss += __shfl_xor(ss, 32);
            LAS float* sb = ssb + (i & 1) * 256;
            if (hh == 0) sb[h * 32 + r] = ss;
            LDS_BAR();
            float tot = 0.f;
#pragma unroll
            for (int w = 0; w < 8; ++w) tot += sb[w * 32 + r];
            const float rn = 1.0f / sqrtf(tot * (1.0f / 512.0f) + EPS);
            bf16* orow = cat + (size_t)tq * D + h * 64 + 4 * hh;
            const LAS float* gp = gain + h * 64 + 4 * hh;
#pragma unroll
            for (int g = 0; g < 4; ++g) {
                const f32x4 g0 = *(const LAS f32x4*)(gp + 8 * g), g1 = *(const LAS f32x4*)(gp + 32 + 8 * g);
                v2u w0, w1;
                w0.x = pkbf(o0[4 * g + 0] * rn * g0.x, o0[4 * g + 1] * rn * g0.y); w0.y = pkbf(o0[4 * g + 2] * rn * g0.z, o0[4 * g + 3] * rn * g0.w);
                w1.x = pkbf(o1[4 * g + 0] * rn * g1.x, o1[4 * g + 1] * rn * g1.y); w1.y = pkbf(o1[4 * g + 2] * rn * g1.z, o1[4 * g + 3] * rn * g1.w);
                *(GAS v2u*)(orow + 8 * g) = w0; *(GAS v2u*)(orow + 32 + 8 * g) = w1;
            }
        }
        __syncthreads();
    }
#pragma nounroll
    for (int rc_ = 0; rc_ < REP_CONV; ++rc_)
    {
        LAS float* ub = (LAS float*)(lds + CL_U);
        LAS float* cb = (LAS float*)(lds + CL_C);
        __builtin_amdgcn_sched_barrier(0);
        int c = tid, ln8 = 8 * lane; asm volatile("" : "+v"(c), "+v"(ln8));
        float w[CW], acc[CW];
#pragma unroll
        for (int j = 0; j < CW; ++j) { w[j] = inp(8)[j * CC + c]; acc[j] = 0.f; }
        const float cbias = inp(9)[c];
        LAS float* lnp = (LAS float*)(lds + 2 * CL_C);
        lnp[c] = inp(10)[c]; lnp[512 + c] = inp(11)[c];
        v4u av[4], gv[4];
#define CONV_LOAD(grp_) do { const int tb_ = -30 + 31 * (grp_); _Pragma("unroll") for (int i4 = 0; i4 < 4; ++i4) { const int it = c + NTHR * i4, s = it >> 6, ch = (it & 63) * 8, tr = tb_ + s; \
            const bool okl = (it < 31 * 64) && tr < 128 && (qb > 0 || tr >= 0); const bf16* pr = proj + (size_t)(t0 + (okl ? tr : 0)) * INC; \
            av[i4] = *(const GAS v4u*)(pr + 768 + ch); gv[i4] = okl ? *(const GAS v4u*)(pr + 1280 + ch) : (v4u){0xff80ff80u, 0xff80ff80u, 0xff80ff80u, 0xff80ff80u}; } } while (0)
        CONV_LOAD(0);
        for (int grp = 0; grp < 6; ++grp) {
            const int tb = -30 + 31 * grp;
#pragma unroll
            for (int i4 = 0; i4 < 4; ++i4) { const int it = c + NTHR * i4, s = it >> 6, ch = (it & 63) * 8;
                if (it < 31 * 64) {
                    f32x4 u0, u1; const v4u a4 = av[i4], g4 = gv[i4];
                    u0.x = bflo(a4.x) * __builtin_amdgcn_rcpf(1.f + __expf(-bflo(g4.x))); u0.y = bfhi(a4.x) * __builtin_amdgcn_rcpf(1.f + __expf(-bfhi(g4.x)));
                    u0.z = bflo(a4.y) * __builtin_amdgcn_rcpf(1.f + __expf(-bflo(g4.y))); u0.w = bfhi(a4.y) * __builtin_amdgcn_rcpf(1.f + __expf(-bfhi(g4.y)));
                    u1.x = bflo(a4.z) * __builtin_amdgcn_rcpf(1.f + __expf(-bflo(g4.z))); u1.y = bfhi(a4.z) * __builtin_amdgcn_rcpf(1.f + __expf(-bfhi(g4.z)));
                    u1.z = bflo(a4.w) * __builtin_amdgcn_rcpf(1.f + __expf(-bflo(g4.w))); u1.w = bfhi(a4.w) * __builtin_amdgcn_rcpf(1.f + __expf(-bfhi(g4.w)));
                    *(LAS f32x4*)(ub + s * 512 + ch) = u0; *(LAS f32x4*)(ub + s * 512 + ch + 4) = u1; } }
            if (grp < 5) CONV_LOAD(grp + 1);
            LDS_BAR();
#pragma unroll
            for (int s = 0; s < CW; ++s) {
                const float u = ub[s * 512 + c];
#pragma unroll
                for (int j = 0; j < CW; ++j) acc[(s + 30 - j) % CW] += w[j] * u;
                cb[s * 512 + c] = acc[s] + cbias; acc[s] = 0.f;
            }
            LDS_BAR();
#pragma nounroll
            for (int itn = 0; itn < 2; ++itn) { const int s = 2 * wave + (lane >> 5) + 16 * itn; const int tr = tb + s; const bool okt = s < CW && tr >= 0 && tr < 128;
                const LAS float* cp = cb + (okt ? s : 0) * 512 + 16 * (lane & 31);
                f32x4 xq[4]; float sm = 0.f;
#pragma unroll
                for (int q4 = 0; q4 < 4; ++q4) { xq[q4] = *(const LAS f32x4*)(cp + 4 * q4); sm += (xq[q4].x + xq[q4].y) + (xq[q4].z + xq[q4].w); }
                sm = dpp16_sum(sm); sm += __shfl_xor(sm, 16);
                const float mu = sm * (1.f / 512.f); float sq = 0.f;
#pragma unroll
                for (int q4 = 0; q4 < 4; ++q4) { xq[q4] = xq[q4] - mu; sq += (xq[q4].x * xq[q4].x + xq[q4].y * xq[q4].y) + (xq[q4].z * xq[q4].z + xq[q4].w * xq[q4].w); }
                sq = dpp16_sum(sq); sq += __shfl_xor(sq, 16);
                const float rs = 1.0f / sqrtf(sq * (1.f / 512.f) + EPS);
                v4u o0, o1;
                { const LAS float* gq = lnp + 16 * (lane & 31); const f32x4 y0 = xq[0] * rs * *(const LAS f32x4*)gq + *(const LAS f32x4*)(gq + 512), y1 = xq[1] * rs * *(const LAS f32x4*)(gq + 4) + *(const LAS f32x4*)(gq + 516); o0.x = pkbf(silu_f(y0.x), silu_f(y0.y)); o0.y = pkbf(silu_f(y0.z), silu_f(y0.w)); o0.z = pkbf(silu_f(y1.x), silu_f(y1.y)); o0.w = pkbf(silu_f(y1.z), silu_f(y1.w)); }
                { const LAS float* gq = lnp + 16 * (lane & 31) + 8; const f32x4 y0 = xq[2] * rs * *(const LAS f32x4*)gq + *(const LAS f32x4*)(gq + 512), y1 = xq[3] * rs * *(const LAS f32x4*)(gq + 4) + *(const LAS f32x4*)(gq + 516); o1.x = pkbf(silu_f(y0.x), silu_f(y0.y)); o1.y = pkbf(silu_f(y0.z), silu_f(y0.w)); o1.z = pkbf(silu_f(y1.x), silu_f(y1.y)); o1.w = pkbf(silu_f(y1.z), silu_f(y1.w)); }
                if (okt) { GAS v4u* op = (GAS v4u*)(cat + (size_t)(t0 + tr) * D + 512 + 16 * (lane & 31)); op[0] = o0; op[1] = o1; }
            }
        }
#undef CONV_LOAD
        __syncthreads();
    }
}

constexpr int CSTRIDE = 64;
__device__ __forceinline__ float dpp8_max(float x) {
    int v = (int)__float_as_uint(x);
#define D8_STEP(ctrl) { const int o = __builtin_amdgcn_update_dpp(v, v, ctrl, 0xf, 0xf, false); v = (int)__float_as_uint(fmaxf(__uint_as_float((unsigned)v), __uint_as_float((unsigned)o))); }
    D8_STEP(0xb1) D8_STEP(0x4e) D8_STEP(0x141)
#undef D8_STEP
    return __uint_as_float((unsigned)v);
}
__device__ __forceinline__ float dpp16_max(float x) {
    int v = (int)__float_as_uint(x);
#define D8_STEP(ctrl) { const int o = __builtin_amdgcn_update_dpp(v, v, ctrl, 0xf, 0xf, false); v = (int)__float_as_uint(fmaxf(__uint_as_float((unsigned)v), __uint_as_float((unsigned)o))); }
    D8_STEP(0xb1) D8_STEP(0x4e) D8_STEP(0x141) D8_STEP(0x140)
#undef D8_STEP
    return __uint_as_float((unsigned)v);
}
__device__ __forceinline__ float dpp8_sum(float x) {
    int v = (int)__float_as_uint(x);
#define D8_STEP(ctrl) { const int o = __builtin_amdgcn_update_dpp(v, v, ctrl, 0xf, 0xf, false); v = (int)__float_as_uint(__uint_as_float((unsigned)v) + __uint_as_float((unsigned)o)); }
    D8_STEP(0xb1) D8_STEP(0x4e) D8_STEP(0x141)
#undef D8_STEP
    return __uint_as_float((unsigned)v);
}
__device__ __forceinline__ void p7_chunk(const Args& a, LAS unsigned char* lds, int tid, int lane, int wave, int ch) {
    unsigned char* ws = a.ws;
    const float* logits = (const float*)(ws + WS_LOGITS);
    int* counts = (int*)(ws + WS_CTL) + CW_COUNTS;
    LAS int* hist = (LAS int*)lds;
    LAS int* cbase = (LAS int*)(lds + 1024);
    LAS float* rbias = (LAS float*)(lds + 2048);
    int* eidx_g = (int*)(ws + WS_EIDX); float* gw_g = (float*)(ws + WS_GW); int* pos_g = (int*)(ws + WS_POS);
    const int g = lane & 7, gb = lane & ~7;
    {
        if (tid < NE) { hist[tid] = 0; rbias[tid] = inp(14)[tid]; }
        __syncthreads();
#pragma nounroll
        for (int ps = 0; ps < 2; ++ps) {
            const int t = ch * 128 + ps * 64 + (tid >> 3);
            float sel[32];
            const GAS f32x4* lp = (const GAS f32x4*)(logits + (size_t)t * NE + 32 * g);
#pragma unroll
            for (int i = 0; i < 8; ++i) { const f32x4 lg = lp[i]; const f32x4 rb = *(const LAS f32x4*)(rbias + 32 * g + 4 * i);
#pragma unroll
                for (int e = 0; e < 4; ++e) sel[4 * i + e] = 1.0f / (1.0f + __expf(-lg[e])) + rb[e]; }
            float m1 = -INFINITY, m2 = -INFINITY;
#pragma unroll
            for (int i = 0; i < 32; ++i) { const float v = sel[i]; m2 = fmaxf(m2, fminf(m1, v)); m1 = fmaxf(m1, v); }
            const float gs = m1 + m2; int rank = 0;
#pragma unroll
            for (int j = 0; j < 8; ++j) { const float o = __shfl(gs, gb + j); rank += (o > gs || (o == gs && j < g)) ? 1 : 0; }
            const bool selected = rank < 4;
            float lv[8]; int li[8];
#pragma unroll
            for (int k = 0; k < 8; ++k) { lv[k] = -INFINITY; li[k] = 0; }
            if (selected) {
#pragma unroll
                for (int i = 0; i < 32; ++i) { float v = sel[i]; int id = 32 * g + i;
#pragma unroll
                    for (int k = 0; k < 8; ++k) { const bool sw = v > lv[k]; const float tv = sw ? lv[k] : v; const int ti = sw ? li[k] : id; lv[k] = sw ? v : lv[k]; li[k] = sw ? id : li[k]; v = tv; id = ti; } }
            }
            float mysel = 0.f; int mye = 0;
#pragma unroll
            for (int rd = 0; rd < TOPK; ++rd) {
                const float mx = dpp8_max(lv[0]);
                const unsigned long long bal = __ballot(lv[0] == mx);
                const int wl = __builtin_ctz((unsigned)((bal >> gb) & 0xffull));
                const int widx = __shfl(li[0], gb + wl);
                if (g == wl) {
#pragma unroll
                    for (int k = 0; k < 7; ++k) { lv[k] = lv[k + 1]; li[k] = li[k + 1]; }
                    lv[7] = -INFINITY; }
                if (g == rd) { mysel = mx; mye = widx; }
            }
            const float mysc = mysel - rbias[mye];
            const float tot = dpp8_sum(mysc);
            const int rk = __hip_atomic_fetch_add(hist + mye, 1, __ATOMIC_RELAXED, __HIP_MEMORY_SCOPE_WORKGROUP);
            eidx_g[t * 8 + g] = mye; gw_g[t * 8 + g] = mysc / tot * 2.5f; pos_g[t * 8 + g] = rk;
        }
        __syncthreads();
        if (tid < NE) { const int c = hist[tid]; cbase[tid] = c > 0 ? atomicAdd(counts + CSTRIDE * tid, c) : 0; }
        __syncthreads();
        for (int i = tid; i < 1024; i += NTHR) { const int idx = ch * 1024 + i; const int e = __builtin_nontemporal_load(eidx_g + idx); const int p = __builtin_nontemporal_load(pos_g + idx) + cbase[e];
            pos_g[idx] = p; ((unsigned short*)(ws + WS_LIST))[(size_t)e * T + p] = (unsigned short)(idx >> 3); (ws + WS_SLOT)[(size_t)e * T + p] = (unsigned char)(idx & 7); }
        __syncthreads();
    }
}
__device__ __forceinline__ int build_tiles(const Args& a, LAS unsigned char* lds, int tid) {
    const int* counts = (const int*)(a.ws + WS_CTL) + CW_COUNTS;
    LAS int* base = (LAS int*)(lds + LX_BASE);
    LAS int* pb = (LAS int*)(lds + LX_GL);
    LAS unsigned short* texp = (LAS unsigned short*)(lds + LX_TEXP);
    if (tid < 64) {
        int c[4], p[4], pre = 0, ppre = 0;
#pragma unroll
        for (int i = 0; i < 4; ++i) { const int raw = __hip_atomic_load(counts + CSTRIDE * (4 * tid + i), RLX_AGENT); ((LAS int*)(lds + LX_CNT))[4 * tid + i] = raw; c[i] = (raw + 255) & ~255; pre += c[i];
            const int nt = c[i] >> 8, ch = (nt > 0 && raw - ((nt - 1) << 8) <= 128) ? 1 : 0; p[i] = ((nt - ch) << 16) | ch; ppre += p[i]; }
        int incl = pre, pincl = ppre;
#pragma unroll
        for (int o = 1; o < 64; o <<= 1) { const int x = __shfl_up(incl, o), y = __shfl_up(pincl, o); if (tid >= o) { incl += x; pincl += y; } }
        int run = incl - pre, prun = pincl - ppre;
#pragma unroll
        for (int i = 0; i < 4; ++i) { base[4 * tid + i] = run; run += c[i]; pb[4 * tid + i] = prun; prun += p[i]; }
        if (tid == 63) { base[NE] = run; base[NE + 1] = run + T; ((LAS int*)(lds + LX_CNT))[NE] = T; pb[NE] = prun; pb[NE + 1] = prun + ((T / 256) << 16); }
    }
    __syncthreads();
    if (tid < NEX) { const int t0 = base[tid] >> 8, t1 = base[tid + 1] >> 8; int fi = pb[tid] >> 16; const int ci = pb[tid] & 0xffff, ch = (pb[tid + 1] & 0xffff) - ci;
        for (int t = t0; t < t1; ++t) { texp[t] = (unsigned short)tid; if (ch && t == t1 - 1) ((LAS unsigned short*)(lds + LX_CT))[ci] = (unsigned short)t; else ((LAS unsigned short*)(lds + LX_FT))[fi++] = (unsigned short)t; } }
    __syncthreads();
    return pb[NEX];
}
__device__ __forceinline__ void p11_phase(const Args& a, LAS unsigned char* lds, int tid, int lane, int wave, int G) {
    unsigned char* ws = a.ws;
    const float* mod = (const float*)(ws + WS_MOD);
    const unsigned char* y = ws + WS_Y;
    const float* gwv = (const float*)(ws + WS_GW);
    const float* xin = a.out; float* out = a.aux ? (float*)(ws + WS_HID) : a.out;
    const float* fg = inp(21);
    typedef float f32x2 __attribute__((ext_vector_type(2)));
    const int gw = blockIdx.x * NWAVES + wave, NGW = G * NWAVES;
    for (int t = gw; t < T; t += NGW) {
        const float* g2 = mod + (size_t)(t >> 12) * 6144 + 5120 + 16 * lane;
        float myw = 0.f;
        if (lane < TOPK) myw = gwv[t * 8 + lane];
        const GAS v4u* yr = (const GAS v4u*)(y + (size_t)t * NSLOT * D + 16 * lane);
        v4u yv[NSLOT];
#pragma unroll
        for (int k = 0; k < NSLOT; ++k) yv[k] = yr[k * (D / 16)];
        f32x4 xv[4];
        { const GAS v4u* xp = (const GAS v4u*)((const bf16*)xin + (size_t)t * (2 * D) + 16 * lane); const v4u x0 = xp[0], x1v = xp[1];
            xv[0] = (f32x4){bflo(x0.x), bfhi(x0.x), bflo(x0.y), bfhi(x0.y)}; xv[1] = (f32x4){bflo(x0.z), bfhi(x0.z), bflo(x0.w), bfhi(x0.w)};
            xv[2] = (f32x4){bflo(x1v.x), bfhi(x1v.x), bflo(x1v.y), bfhi(x1v.y)}; xv[3] = (f32x4){bflo(x1v.z), bfhi(x1v.z), bflo(x1v.w), bfhi(x1v.w)}; }
        f32x4 m4[4];
#pragma unroll
        for (int j = 0; j < 4; ++j) m4[j] = (f32x4){0.f, 0.f, 0.f, 0.f};
#pragma unroll
        for (int k = 0; k < NSLOT; ++k) {
            const float wk = k < TOPK ? __uint_as_float((unsigned)__builtin_amdgcn_readlane((int)__float_as_uint(myw), k < TOPK ? k : 0)) : 1.0f;
#pragma unroll
            for (int j = 0; j < 4; ++j) { const f32x2 lo = __builtin_amdgcn_cvt_pk_f32_fp8((int)yv[k][j], false), hi = __builtin_amdgcn_cvt_pk_f32_fp8((int)yv[k][j], true);
                m4[j] += (f32x4){lo.x, lo.y, hi.x, hi.y} * wk; }
        }
        f32x4 v[4]; float s = 0.f;
#pragma unroll
        for (int j = 0; j < 4; ++j) { v[j] = xv[j] + *(const f32x4*)(g2 + 4 * j) * m4[j]; s += (v[j].x * v[j].x + v[j].y * v[j].y) + (v[j].z * v[j].z + v[j].w * v[j].w); }
        const float r = 1.0f / sqrtf(wave_sum_dpp(s) * (1.f / D) + EPS);
#pragma unroll
        for (int j = 0; j < 4; ++j) *(GAS f32x4*)(out + (size_t)t * D + 16 * lane + 4 * j) = v[j] * r * *(const f32x4*)(fg + 16 * lane + 4 * j);
    }
}

__global__ void __launch_bounds__(NTHR, 2) hyb_fwd(Args args) {
    extern __shared__ __attribute__((aligned(16))) unsigned char lds_raw[];
    LAS unsigned char* lds = (LAS unsigned char*)lds_raw;
    volatile LAS unsigned* MISC = (volatile LAS unsigned*)(lds + LX_MISC);
    const int tid = threadIdx.x, lane = tid & 63, wave = __builtin_amdgcn_readfirstlane(tid >> 6), G = gridDim.x;
    unsigned char* ws = args.ws;
    if (tid < 64) MISC[tid] = 0u;
    __syncthreads();
    XcdBarrier bar; bar.bar = (unsigned*)(ws + WS_CTL) + CW_BAR; bar.x = 0; bar.st = nullptr;
    if (!MK_MULTI) bar = xcd_barrier_post((unsigned*)(ws + WS_CTL) + CW_BAR, MISC + 8);
    const int lo = args.ph_lo, hi = args.ph_hi;
#ifndef PH_REPEAT
#define PH_REPEAT 0
#endif
#define IN(k) (lo <= (k) && (k) < hi)
#define SEAM(k) do { if (IN(k) && IN((k) + 1)) xcd_barrier(bar); } while (0)
#define SEAM_LOCAL(k) do { if (IN(k) && IN((k) + 1)) { if (lok) xcd_local_barrier(bar); else xcd_barrier(bar); } } while (0)
    bool lok = false; int vid = (int)blockIdx.x;
#define REP(k) for (int rep_ = 0; rep_ < (((PH_REPEAT >> (k)) & 1) ? 2 : 1); ++rep_, (((PH_REPEAT >> (k)) & 1) && rep_ == 1 ? xcd_barrier(bar) : (void)0))
    const float* mod = (const float*)(ws + WS_MOD);
    bf16* Hb = (bf16*)(ws + WS_H);

#ifndef PAD_NOPS
#define PAD_NOPS 0
#endif
    if (PAD_NOPS > 0 && G == 0x7fffffff) { _Pragma("unroll") for (int pn_ = 0; pn_ < PAD_NOPS; ++pn_) asm volatile("s_nop 0"); }
    if (IN(0)) { REP(0) { p0_phase(args, lds, tid, lane, wave, G); } if (MK_MULTI) SEAM(0); }
    if (IN(1)) { REP(1) {
        if (!MK_MULTI) { if (tid == 0) { unsigned sp_ = 0; const unsigned need = G < 192 ? (unsigned)G : 192u;
                while (__hip_atomic_load((unsigned*)(ws + WS_CTL) + CW_SHQ, __ATOMIC_RELAXED, __HIP_MEMORY_SCOPE_AGENT) < need) { __builtin_amdgcn_s_sleep(2); if (++sp_ > (1u << 22)) break; }
                __builtin_amdgcn_fence(__ATOMIC_ACQUIRE, "agent"); asm volatile("s_waitcnt vmcnt(0)" ::: "memory"); }
            __syncthreads(); }
        norm_quant_phase(inp(0), (unsigned char*)Hb, (float*)(ws + WS_SA1), mod, lane, wave, G); } SEAM(1);
        if (!MK_MULTI && IN(2)) { lok = MISC[11] != 0u && (G & 7) == 0 && G == 2 * (T / 256); if (lok) vid = (int)MISC[10] * 8 + (int)bar.x; } }
    if (IN(2)) { REP(2) {
        pg8::MoeStream MS{(const unsigned char*)Hb, ws + WS_WINQ, (const float*)(ws + WS_SWIN), (bf16*)(ws + WS_PROJ), nullptr, nullptr, (const float*)(ws + WS_SA1), nullptr, nullptr, nullptr, nullptr, nullptr, nullptr, 0};
        MS.order.init(T, INC, G, vid);
        pg8::moe_stream<2>(lds, MS);
        } SEAM_LOCAL(2);
    }
    if (IN(3)) { REP(3) { for (int u0 = vid; u0 < NB * 32; u0 += G) { const int u = lok ? (u0 & 7) * (NB * 32 / 8) + (u0 >> 3) : u0;
            p3_unit(args, lds, u, tid, lane, wave); } } SEAM_LOCAL(3); }
    if (IN(4)) { REP(4) {
        pg8::Gemm g{(const bf16*)(ws + WS_CAT), (const bf16*)(ws + WS_WOUT), T, D, D};
        bf16* H2 = Hb;
        for (int rnd = 0; rnd * G < (T / 256) * (D / 256); ++rnd) {
            pg8::RoundSched S; S.base.init(T, D, G, vid); S.round = rnd;
            pg8::EpiResidNorm E{inp(0), args.out, mod, H2, (float*)(ws + WS_XSLOTS), (unsigned*)(ws + WS_CTL) + CW_PANEL + rnd * 128 * 64, EPS};
            pg8::gemm_phase<pg8::EpiResidNorm, pg8::RoundSched, false, true>(lds, g, S, E);
        }
        } SEAM_LOCAL(5);
    }
    if (IN(6)) { REP(6) {
        unsigned* rflag = (unsigned*)(ws + WS_CTL) + CW_RFLAG;
        const int b7_ = vid & (T / 256 - 1), u = lok ? (b7_ & 7) * (T / 256 / 8) + (b7_ >> 3) : b7_;
        if (vid < T / 256) {
            pg8::Gemm g{Hb, (const bf16*)(ws + WS_WRS), T, 256, D}; pg8::OneUnit S{u, 0};
            pg8::EpiRouterShared E{(float*)(ws + WS_LOGITS), nullptr};
            pg8::gemm_phase<pg8::EpiRouterShared, pg8::OneUnit, true, true>(lds, g, S, E);
            asm volatile("s_waitcnt vmcnt(0)" ::: "memory"); __syncthreads();
            if (tid == 0) { if (!lok) { __builtin_amdgcn_fence(__ATOMIC_RELEASE, "agent"); asm volatile("s_waitcnt vmcnt(0)" ::: "memory"); }
                __hip_atomic_store(rflag + 16 * u, 1u, __ATOMIC_RELAXED, __HIP_MEMORY_SCOPE_AGENT); }
        } else {
            quant_rows(Hb, ws + WS_H2Q, (float*)(ws + WS_SA), (LAS float*)(lds + LX_RS), u * 256, lane, wave);
            if (tid == 0) { unsigned sp_ = 0; while (__hip_atomic_load(rflag + 16 * u, __ATOMIC_RELAXED, __HIP_MEMORY_SCOPE_AGENT) == 0u) { __builtin_amdgcn_s_sleep(2); if (++sp_ > (1u << 22)) break; }
                __builtin_amdgcn_fence(__ATOMIC_ACQUIRE, "agent"); asm volatile("s_waitcnt vmcnt(0)" ::: "memory"); }
            __syncthreads();
        }
        p7_chunk(args, lds, tid, lane, wave, 2 * u + (vid < T / 256 ? 0 : 1));
        } SEAM(7);
    }
    if (IN(9)) { REP(9) {
        const int fc = build_tiles(args, lds, tid), nfull = fc >> 16, ncheap = fc & 0xffff;
        const LAS unsigned short* texp = (const LAS unsigned short*)(lds + LX_TEXP);
        int xq = 0, wi = vid, step = G, sh = 0;
        if ((G & 7) == 0) { xq = vid & 7; wi = vid >> 3; step = G >> 3; sh = 3; }
        const int f_lo = (int)(((long)xq * nfull) >> sh), f_hi = (int)(((long)(xq + 1) * nfull) >> sh), c_lo = (int)(((long)xq * ncheap) >> sh), c_hi = (int)(((long)(xq + 1) * ncheap) >> sh);
        const int nF = f_hi - f_lo, nC = c_hi - c_lo;
        const int nf = wi < nF ? (nF - wi + step - 1) / step : 0;
        const int j0 = (((wi - nF) % step) + step) % step;
        const int nc = j0 < nC ? (nC - j0 + step - 1) / step : 0;
        const int ntl = nf + nc;
        LAS unsigned short* mt = (LAS unsigned short*)(lds + LX_MY); LAS unsigned short* mr = mt + 16;
        for (int tl0 = 0; tl0 < ntl; tl0 += 6) {
            const int nn = (ntl - tl0) < 6 ? (ntl - tl0) : 6;
            if (tid < nn) { const int idx = tl0 + tid; const int t = idx < nf ? (int)((const LAS unsigned short*)(lds + LX_FT))[f_lo + wi + step * idx] : (int)((const LAS unsigned short*)(lds + LX_CT))[c_lo + j0 + step * (idx - nf)];
                const int ex = (int)texp[t]; int R = ((const LAS int*)(lds + LX_CNT))[ex] - (t * 256 - ((const LAS int*)(lds + LX_BASE))[ex]); R = R > 256 ? 256 : R; mt[tid] = (unsigned short)t; mr[tid] = (unsigned short)R; }
            __syncthreads();
            LAS unsigned short* gl = (LAS unsigned short*)(lds + LX_GL);
            for (int i = tid; i < nn * 256; i += NTHR) { const int sl = i >> 8, r = i & 255, pm = (int)mt[sl]; const int ex = (int)texp[pm], r0 = pm * 256 - ((const LAS int*)(lds + LX_BASE))[ex];
                const bool realr = r < (int)mr[sl];
                const unsigned short tk = !realr ? (unsigned short)0 : (ex == NE ? (unsigned short)(r0 + r) : ((const unsigned short*)(ws + WS_LIST))[(size_t)ex * T + r0 + r]);
                gl[i] = tk; ((LAS float*)(lds + LX_RS))[i] = ((const float*)(ws + WS_SA))[tk];
            }
            for (int i = tid; i < nn * 512; i += NTHR) ((LAS float*)(lds + LX_DST))[i] = ((const float*)(ws + WS_SWGU))[(size_t)texp[mt[i >> 9]] * 512 + (i & 511)];
            if (tid < nn * 8) ((LAS float*)(lds + LX_MY + 64))[tid] = ((const float*)(ws + WS_SWD))[(size_t)texp[mt[tid >> 3]] * 8 + (tid & 7)];
            __syncthreads();
            pg8::MoeStream MS{ws + WS_H2Q, ws + WS_WGU, (const float*)(ws + WS_SWGU), (bf16*)(ws + WS_HID), nullptr, nullptr, nullptr, nullptr, texp, gl, (const LAS float*)(lds + LX_RS), mt, mr, nn}; MS.lsc = (const LAS float*)(lds + LX_DST);
            pg8::moe_stream<0>(lds, MS);
#ifdef PROBE_G1
            __syncthreads(); pg8::moe_stream<0, PROBE_G1>(lds, MS);
#endif
            asm volatile("s_waitcnt vmcnt(0)" ::: "memory"); __syncthreads();
            for (int i = tid; i < nn * 256; i += NTHR) { const int sl = i >> 8, r = i & 255, pm = (int)mt[sl]; const int ex = (int)texp[pm], r0 = pm * 256 - ((const LAS int*)(lds + LX_BASE))[ex];
                ((LAS int*)(lds + LX_DST))[i] = r >= (int)mr[sl] ? -1 : (int)gl[i] * NSLOT + (ex == NE ? TOPK : (int)(ws + WS_SLOT)[(size_t)ex * T + r0 + r]); }
            {
                const bf16* hidp = (const bf16*)(ws + WS_HID); unsigned char* hq = ws + WS_HIDQ; LAS float* rsl = (LAS float*)(lds + LX_RS);
                const int l16 = lane & 15;
                for (int rb = wave * 4 + (lane >> 4); rb < nn * 256; rb += NWAVES * 4 * 4) {
                    v4u a0[4], a1[4]; size_t grow[4];
#pragma unroll
                    for (int u4 = 0; u4 < 4; ++u4) { const int rr = rb + u4 * NWAVES * 4; const int rc = rr < nn * 256 ? rr : rb; const int sl = rc >> 8, r = rc & 255; grow[u4] = (size_t)mt[sl] * 256 + r;
                        const GAS v4u* sp = (const GAS v4u*)(hidp + grow[u4] * 256 + 16 * l16); a0[u4] = sp[0]; a1[u4] = sp[1]; }
#pragma unroll
                    for (int u4 = 0; u4 < 4; ++u4) { const int rr = rb + u4 * NWAVES * 4;
                        float v[16];
                        v[0] = bflo(a0[u4].x); v[1] = bfhi(a0[u4].x); v[2] = bflo(a0[u4].y); v[3] = bfhi(a0[u4].y); v[4] = bflo(a0[u4].z); v[5] = bfhi(a0[u4].z); v[6] = bflo(a0[u4].w); v[7] = bfhi(a0[u4].w);
                        v[8] = bflo(a1[u4].x); v[9] = bfhi(a1[u4].x); v[10] = bflo(a1[u4].y); v[11] = bfhi(a1[u4].y); v[12] = bflo(a1[u4].z); v[13] = bfhi(a1[u4].z); v[14] = bflo(a1[u4].w); v[15] = bfhi(a1[u4].w);
                        float mxv = 0.f;
#pragma unroll
                        for (int i = 0; i < 16; ++i) mxv = fmaxf(mxv, fabsf(v[i]));
                        mxv = dpp16_max(mxv);
                        const float sc = mxv > 0.f ? mxv * (1.0f / 127.0f) : 1.0f, iv = 1.0f / sc;
                        unsigned q[4];
#pragma unroll
                        for (int w4 = 0; w4 < 4; ++w4) { unsigned pk = 0u;
#pragma unroll
                            for (int b = 0; b < 4; ++b) { int qi = (int)rintf(v[4 * w4 + b] * iv); qi = qi > 127 ? 127 : (qi < -127 ? -127 : qi); pk |= ((unsigned)qi & 0xffu) << (8 * b); }
                            q[w4] = pk; }
                        if (rr < nn * 256 && (rr & 255) < (int)mr[rr >> 8]) { *(GAS v4u*)(hq + grow[u4] * 256 + 16 * l16) = (v4u){q[0], q[1], q[2], q[3]};
                            if (l16 == 0) rsl[rr] = sc; } }
                }
                asm volatile("s_waitcnt vmcnt(0)" ::: "memory"); __syncthreads();
            }
            {
                pg8::MoeStream MD{nullptr, nullptr, nullptr, nullptr, ws + WS_HIDQ, ws + WS_WD, (const float*)(ws + WS_SWD), ws + WS_Y, texp, nullptr, (const LAS float*)(lds + LX_RS), mt, mr, nn}; MD.dst = (const LAS int*)(lds + LX_DST); MD.lsc = (const LAS float*)(lds + LX_MY + 64);
                pg8::moe_stream<1>(lds, MD);
#ifdef PROBE_G2
                __syncthreads(); pg8::moe_stream<1, PROBE_G2>(lds, MD);
#endif
            }
            __syncthreads();
        }
        } SEAM(10);
    }
    if (IN(11)) { REP(11) { p11_phase(args, lds, tid, lane, wave, G); } }
#undef IN
#undef SEAM
}

extern "C" void kernel_launch(void* const* d_in, const int* in_sizes, int n_in, void* d_out, int out_size, void* d_ws, size_t ws_size, hipStream_t stream) {
    static int grid = 0;
    if (grid == 0) {
        if (n_in != 22 || in_sizes[0] != T * D || out_size != T * D || ws_size < WS_NEED) { fprintf(stderr, "kernel_launch: unexpected shapes (n_in %d, in0 %d, out %d, ws %zu); nothing launched\n", n_in, n_in > 0 ? in_sizes[0] : -1, out_size, ws_size); grid = -1; return; }
        int dev = 0, cus = 0, per_cu = 0;
        if (hipGetDevice(&dev) != hipSuccess || hipDeviceGetAttribute(&cus, hipDeviceAttributeMultiprocessorCount, dev) != hipSuccess) { grid = -1; return; }
        if (hipFuncSetAttribute((const void*)hyb_fwd, hipFuncAttributeMaxDynamicSharedMemorySize, LDS_BYTES) != hipSuccess) { fprintf(stderr, "kernel_launch: hipFuncSetAttribute failed\n"); grid = -1; return; }
        if (hipOccupancyMaxActiveBlocksPerMultiprocessor(&per_cu, (const void*)hyb_fwd, NTHR, LDS_BYTES) != hipSuccess || per_cu < 1) { fprintf(stderr, "kernel_launch: occupancy query says %d\n", per_cu); }
        (void)hipGetLastError();
        grid = cus;
        if (grid != 2 * (T / 256)) { fprintf(stderr, "kernel_launch: %d CUs, the phase layout needs %d workgroups; nothing launched\n", cus, 2 * (T / 256)); grid = -1; return; }
    }
    if (grid < 0) return;
    if (hipMemsetAsync((char*)d_ws + WS_CTL, 0, CTL_ZERO_BYTES, stream) != hipSuccess) return;
    Args a{};
    for (int i = 0; i < 22; ++i) a.in[i] = (const float*)d_in[i];
    a.out = (float*)d_out; a.ws = (unsigned char*)d_ws;
#if MK_MULTI
#ifndef HOST_REPEAT
#define HOST_REPEAT 0
#endif
    for (int p = 0; p < NPHASE; ++p) for (int r = 0; r < (((HOST_REPEAT >> p) & 1) ? 2 : 1); ++r) { a.ph_lo = p; a.ph_hi = p + 1;
        const bool rep = ((HOST_REPEAT >> p) & 1) != 0;
        a.aux = ((p == 11 || p == 9) && rep && r == 0) ? 1 : 0;
        if (p == 7 && rep && r == 1) (void)hipMemsetAsync((char*)d_ws + WS_CTL + CW_COUNTS * 4, 0, 256 * 64 * 4, stream);
        hipLaunchKernelGGL(hyb_fwd, dim3(grid), dim3(NTHR), LDS_BYTES, stream, a); }
#else
    a.ph_lo = 0; a.ph_hi = NPHASE;
    hipLaunchKernelGGL(hyb_fwd, dim3(grid), dim3(NTHR), LDS_BYTES, stream, a);
#endif
}
```
